# Optimizing an MI355X kernel written in HIP

```python
import jax, jax.numpy as jnp
from jax import lax
import numpy as np

D_MODEL = 2048
BATCH = 2
SEQ = 4096
DEPTH = 1

CONV_DIM = 1024
CONV_GROUPS = 8
CONV_WIDTH = 3
N_HEADS = 16
QK_NOPE_DIM = 128
QK_ROPE_DIM = 64
QK_HEAD_DIM = QK_NOPE_DIM + QK_ROPE_DIM
V_HEAD_DIM = 128
Q_LORA_RANK = 768
KV_LORA_RANK = 512
ROPE_THETA = 10000.0
Q_BLOCK = 128
D_FF = 5632
NORM_EPS = 1e-6
NEG_INF = -1e30

IN_SIZES = (CONV_DIM, CONV_DIM, CONV_DIM, Q_LORA_RANK, KV_LORA_RANK, QK_ROPE_DIM, 2 * D_MODEL)
IN_WIDTH = sum(IN_SIZES)
IN_SPLIT_IDX = tuple(int(i) for i in np.cumsum(IN_SIZES)[:-1])

kernel_name = "hybrid_gated_conv_mla_convffn_block"


def rmsnorm(x, g):
    xf = x.astype(jnp.float32)
    r = lax.rsqrt(jnp.mean(xf * xf, axis=-1, keepdims=True) + NORM_EPS)
    return (xf * r).astype(x.dtype) * g


def causal_dwconv3(u, w):
    s = u.shape[1]
    up = jnp.pad(u, ((0, 0), (CONV_WIDTH - 1, 0), (0, 0)))
    y = w[0] * up[:, 0:s]
    for k in range(1, CONV_WIDTH):
        y = y + w[k] * up[:, k:k + s]
    return y


def rope_tables(positions, dtype):
    inv_freq = ROPE_THETA ** (-jnp.arange(0, QK_ROPE_DIM, 2, dtype=jnp.float32) / QK_ROPE_DIM)
    ang = positions.astype(jnp.float32)[..., None] * inv_freq
    cos = jnp.cos(ang)[:, :, None, :].astype(dtype)
    sin = jnp.sin(ang)[:, :, None, :].astype(dtype)
    return cos, sin


def apply_rope_tail(x, cos, sin):
    x_nope = x[..., :QK_NOPE_DIM]
    x_r = x[..., QK_NOPE_DIM:]
    x1, x2 = jnp.split(x_r, 2, axis=-1)
    rot = jnp.concatenate([x1 * cos - x2 * sin, x2 * cos + x1 * sin], axis=-1)
    return jnp.concatenate([x_nope, rot], axis=-1)


def causal_block_attention(q, k, v):
    b, s, h, dk = q.shape
    dv = v.shape[-1]
    nb = s // Q_BLOCK
    scale = dk ** -0.5
    qb = q.reshape(b, nb, Q_BLOCK, h, dk).transpose(1, 0, 3, 2, 4)
    kh = k.transpose(0, 2, 1, 3)
    vh = v.transpose(0, 2, 1, 3)
    kpos = jnp.arange(s)

    def one_block(args):
        q_blk, blk = args
        sc = jnp.einsum('bhqd,bhkd->bhqk', q_blk, kh).astype(jnp.float32) * scale
        qpos = blk * Q_BLOCK + jnp.arange(Q_BLOCK)
        mask = kpos[None, :] <= qpos[:, None]
        sc = jnp.where(mask, sc, NEG_INF)
        p = jax.nn.softmax(sc, axis=-1).astype(vh.dtype)
        return jnp.einsum('bhqk,bhkd->bhqd', p, vh)

    o = lax.map(one_block, (qb, jnp.arange(nb)))
    return o.transpose(1, 0, 3, 2, 4).reshape(b, s, h * dv)


def setup_inputs(seed: int = 0) -> dict:
    key = jax.random.key(seed)
    ks = jax.random.split(key, 20)

    def dense(k, fan_in, fan_out):
        return jax.random.normal(k, (DEPTH, fan_in, fan_out), jnp.float32) * fan_in ** -0.5

    def gain(k, n):
        return 1.0 + 0.02 * jax.random.normal(k, (DEPTH, n), jnp.float32)

    x = jax.random.normal(ks[0], (BATCH, SEQ, D_MODEL), jnp.float32)
    positions = jnp.broadcast_to(jnp.arange(SEQ, dtype=jnp.int32), (BATCH, SEQ))
    return {
        "x": x,
        "positions": positions,
        "ln1_g": gain(ks[1], D_MODEL),
        "w_in": dense(ks[2], D_MODEL, IN_WIDTH),
        "b_gate": 0.01 * jax.random.normal(ks[3], (DEPTH, 2 * D_MODEL), jnp.float32),
        "conv_w": jax.random.normal(ks[4], (DEPTH, CONV_WIDTH, CONV_DIM), jnp.float32) * CONV_WIDTH ** -0.5,
        "w_conv_out": dense(ks[5], CONV_DIM, D_MODEL),
        "q_a_g": gain(ks[6], Q_LORA_RANK),
        "w_q_b": dense(ks[7], Q_LORA_RANK, N_HEADS * QK_HEAD_DIM),
        "kv_a_g": gain(ks[8], KV_LORA_RANK),
        "w_kv_b": dense(ks[9], KV_LORA_RANK, N_HEADS * (QK_NOPE_DIM + V_HEAD_DIM)),
        "q_norm_g": gain(ks[10], QK_HEAD_DIM),
        "k_norm_g": gain(ks[11], QK_HEAD_DIM),
        "w_mla_out": dense(ks[12], N_HEADS * V_HEAD_DIM, D_MODEL),
        "w_o": dense(ks[13], D_MODEL, D_MODEL),
        "ln2_g": gain(ks[14], D_MODEL),
        "w_ffn_up": dense(ks[15], D_MODEL, 2 * D_FF),
        "ffn_conv_w": jax.random.normal(ks[16], (DEPTH, CONV_WIDTH, 2 * D_FF), jnp.float32) * CONV_WIDTH ** -0.5,
        "ffn_conv_b": 0.01 * jax.random.normal(ks[17], (DEPTH, 2 * D_FF), jnp.float32),
        "w_ffn_down": dense(ks[18], D_FF, D_MODEL),
    }


def reference(x, positions, ln1_g, w_in, b_gate, conv_w, w_conv_out, q_a_g, w_q_b, kv_a_g, w_kv_b,
              q_norm_g, k_norm_g, w_mla_out, w_o, ln2_g, w_ffn_up, ffn_conv_w, ffn_conv_b, w_ffn_down):
    b, s, _ = x.shape
    cos, sin = rope_tables(positions, x.dtype)
    h = x
    for l in range(DEPTH):
        u = rmsnorm(h, ln1_g[l])
        z = u @ w_in[l]
        zb, zc, zv, q_lat, kv_lat, k_rope, gates = jnp.split(z, IN_SPLIT_IDX, axis=-1)
        gates = jax.nn.sigmoid(gates + b_gate[l])
        gate_a, gate_b = jnp.split(gates, 2, axis=-1)

        y_conv = (zb * causal_dwconv3(zc * zv, conv_w[l])) @ w_conv_out[l]

        q = (rmsnorm(q_lat, q_a_g[l]) @ w_q_b[l]).reshape(b, s, N_HEADS, QK_HEAD_DIM)
        kv = (rmsnorm(kv_lat, kv_a_g[l]) @ w_kv_b[l]).reshape(b, s, N_HEADS, QK_NOPE_DIM + V_HEAD_DIM)
        k_nope, v = jnp.split(kv, [QK_NOPE_DIM], axis=-1)
        k = jnp.concatenate(
            [k_nope, jnp.broadcast_to(k_rope[:, :, None, :], (b, s, N_HEADS, QK_ROPE_DIM))], axis=-1)
        q = apply_rope_tail(rmsnorm(q, q_norm_g[l]), cos, sin)
        k = apply_rope_tail(rmsnorm(k, k_norm_g[l]), cos, sin)
        y_mla = causal_block_attention(q, k, v) @ w_mla_out[l]

        h = h + (gate_a * y_conv + gate_b * y_mla) @ w_o[l]

        u = rmsnorm(h, ln2_g[l])
        a = causal_dwconv3(u @ w_ffn_up[l], ffn_conv_w[l]) + ffn_conv_b[l]
        a_gate, a_up = jnp.split(a, 2, axis=-1)
        h = h + (jax.nn.silu(a_gate) * a_up) @ w_ffn_down[l]
    return h
```

```cpp
#include <hip/hip_runtime.h>
#include <hip/hip_cooperative_groups.h>
#include <hip/hip_bf16.h>
#include <cstdio>
#include <cstdint>
namespace cg = cooperative_groups;
namespace pg8 {
#define PG8_LAS __attribute__((address_space(3)))
typedef unsigned short bf16_t;
typedef short bf16x8 __attribute__((ext_vector_type(8)));
typedef float f32x4 __attribute__((ext_vector_type(4)));
typedef unsigned u32x4 __attribute__((ext_vector_type(4)));
constexpr int BM = 256, BK = 64, HALF = 128, HTB = HALF * BK * 2  , STAGE_BYTES = 8 * HTB, NXCD = 8, WGM = 4;

__host__ __device__ __forceinline__ int lds_byte(int r, int c) { const int st = (r >> 4) * 2 + (c >> 5), rr = r & 15, cc = c & 31, ob = rr * 64 + cc * 2; return st * 1024 + (ob ^ (((ob >> 9) & 1) << 5)); }
__host__ __device__ __forceinline__ void stage_rc(int b, int& R, int& C) { const int st = b / 1024, sb = b % 1024, swz = sb ^ (((sb >> 9) & 1) << 5); R = (st >> 1) * 16 + swz / 64; C = (st & 1) * 32 + (swz % 64) / 2; }
__host__ __device__ __forceinline__ int perm32(int rho) { const int n = rho >> 4, i = rho & 15; return 8 * (i >> 2) + 4 * n + (i & 3); }

struct Unit { int pm, pn; };
struct Gemm { const bf16_t* A; const bf16_t* Bt; int M, N, K; };

struct StaticOrder {
    int nM, nN, nwg, G, c;
    __host__ __device__ void init(int M, int N, int G_, int c_) { nM = M / BM; nN = N / BM; nwg = nM * nN; G = G_; c = c_; }
    __host__ __device__ bool next(int i, Unit& u) const {
        const long L = (long)i * G + c; if (L >= nwg) return false;
        int wgid = (int)L; { const int q = nwg / NXCD, r = nwg % NXCD, xcd = wgid % NXCD, off = wgid / NXCD; wgid = (xcd < r ? xcd * (q + 1) : r * (q + 1) + (xcd - r) * q) + off; }
        const int nig = WGM * nN, gid = wgid / nig, fm = gid * WGM, gsz = (nM - fm) < WGM ? (nM - fm) : WGM;
        u.pm = fm + ((wgid % nig) % gsz); u.pn = (wgid % nig) / gsz; return true;
    }
    __device__ __forceinline__ int a_row(const Unit& u) const { return u.pm * BM; }
    __device__ __forceinline__ void a_ready(const Unit&) const {}
    __device__ __forceinline__ void done(const Unit&) const {}
};
struct UpOrder {
    int nM, nN, nwg, G, c;
    __host__ __device__ void init(int G_, int c_) { nM = 34; nN = 44; nwg = nM * nN; G = G_; c = c_; }
    __host__ __device__ bool next(int i, Unit& u) const {
        const long L = (long)i * G + c; if (L >= nwg) return false;
        int wgid = (int)L; { const int q = nwg / NXCD, r = nwg % NXCD, xcd = wgid % NXCD, off = wgid / NXCD; wgid = (xcd < r ? xcd * (q + 1) : r * (q + 1) + (xcd - r) * q) + off; }
        const int nig = WGM * nN, gid = wgid / nig, fm = gid * WGM, gsz = (nM - fm) < WGM ? (nM - fm) : WGM;
        u.pm = fm + ((wgid % nig) % gsz); u.pn = (wgid % nig) / gsz; return true;
    }
    __device__ __forceinline__ int a_row(const Unit& u) const { return (u.pm / 17) * 4096 + 254 * (u.pm % 17) - 2; }
    __device__ __forceinline__ void a_ready(const Unit&) const {}
    __device__ __forceinline__ void done(const Unit&) const {}
};

__device__ __forceinline__ unsigned cvt_pk_bf16(float lo, float hi) { unsigned r; asm volatile("v_cvt_pk_bf16_f32 %0, %1, %2" : "=v"(r) : "v"(lo), "v"(hi)); return r; }
typedef float f32x2 __attribute__((ext_vector_type(2)));
__device__ __forceinline__ f32x2 gelu_pk(f32x2 v) {
    const f32x2 av = __builtin_elementwise_abs(v), d = av * 0.2316418882f + 1.0f;
    f32x2 t; t.x = __builtin_amdgcn_rcpf(d.x); t.y = __builtin_amdgcn_rcpf(d.y);
    f32x2 q = t * 0.5307027145f + (-0.7265760135f); q = q * t + 0.7107068705f; q = q * t + (-0.142248368f); q = q * t + 0.127414796f; q = q * t;
    const f32x2 s = (v * v) * (-0.72134752044f);
    f32x2 e; e.x = __builtin_amdgcn_exp2f(s.x); e.y = __builtin_amdgcn_exp2f(s.y);
    const f32x2 m = v * (q * e), r = v - m;
    f32x2 o; o.x = v.x < 0.f ? m.x : r.x; o.y = v.y < 0.f ? m.y : r.y; return o;
}

template <int ACT  > struct EpiBf16 {
    static constexpr bool PERM = true, AFTER_DRAIN = false; static_assert(ACT == 0 || ACT == 1, "EpiBf16: ACT is 0 (none) or 1 (gelu_pk)");
    bf16_t* O; int ldc; const float* bias; int split_cols; size_t split_stride; float scale0;
    __device__ __forceinline__ void operator()(const f32x4 (&acc)[2][2][4][2], const Unit& u, int wr, int wc, int fr, int fq) const {
        const int row0 = u.pm * BM + wr * 64 + fr; int colt = u.pn * BM; bf16_t* base = O;
        float sc = 1.f; if (split_cols) { const int t = colt / split_cols; base += (size_t)t * split_stride; colt -= t * split_cols; if (t == 0) sc = scale0; }
        const int col0 = colt + wc * 32 + 8 * fq, bcol0 = u.pn * BM + wc * 32 + 8 * fq;
        f32x4 bv[2][2];
#pragma unroll
        for (int bj = 0; bj < 2; ++bj)
#pragma unroll
            for (int n = 0; n < 2; ++n) bv[bj][n] = bias ? *(const f32x4*)(bias + bcol0 + bj * HALF + 4 * n) : (f32x4){0.f, 0.f, 0.f, 0.f};
#pragma unroll
        for (int ai = 0; ai < 2; ++ai)
#pragma unroll
            for (int m = 0; m < 4; ++m) { bf16_t* rowp = base + (size_t)(row0 + ai * HALF + m * 16) * ldc + col0;
#pragma unroll
                for (int bj = 0; bj < 2; ++bj) { f32x4 v0 = acc[ai][bj][m][0] + bv[bj][0], v1 = acc[ai][bj][m][1] + bv[bj][1];
                    if (ACT == 1) { f32x2 a = gelu_pk((f32x2){v0[0], v0[1]}), b = gelu_pk((f32x2){v0[2], v0[3]}), c = gelu_pk((f32x2){v1[0], v1[1]}), d = gelu_pk((f32x2){v1[2], v1[3]});
                        v0 = (f32x4){a.x, a.y, b.x, b.y}; v1 = (f32x4){c.x, c.y, d.x, d.y}; }
                    v0 = v0 * sc; v1 = v1 * sc; u32x4 w; w.x = cvt_pk_bf16(v0[0], v0[1]); w.y = cvt_pk_bf16(v0[2], v0[3]); w.z = cvt_pk_bf16(v1[0], v1[1]); w.w = cvt_pk_bf16(v1[2], v1[3]);
                    *(u32x4*)(rowp + bj * HALF) = w; } }
    }
};
__device__ __forceinline__ float sigmoid_f(float x) { return __builtin_amdgcn_rcpf(1.0f + __builtin_amdgcn_exp2f(-1.4426950408889634f * x)); }
__device__ __forceinline__ float bf_lo(unsigned w) { return __uint_as_float(w << 16); }
__device__ __forceinline__ float bf_hi(unsigned w) { return __uint_as_float(w & 0xffff0000u); }
__device__ __forceinline__ float sum_rows4(float s) {
    { auto r = __builtin_amdgcn_permlane16_swap(__float_as_uint(s), __float_as_uint(s), false, false); s = __uint_as_float(r[0]) + __uint_as_float(r[1]); }
    { auto r = __builtin_amdgcn_permlane32_swap(__float_as_uint(s), __float_as_uint(s), false, false); s = __uint_as_float(r[0]) + __uint_as_float(r[1]); }
    return s;
}
struct EpiIn {
    static constexpr bool PERM = true, AFTER_DRAIN = false;
    bf16_t *zconv, *zq, *zkv, *zg, *zkr; const float* bgate;
    __device__ __forceinline__ void operator()(const f32x4 (&acc)[2][2][4][2], const Unit& u, int wr, int wc, int fr, int fq) const {
        const int pn = u.pn; bf16_t* dst; int ldc, ct, mode = 0;
        if (pn < 12) { dst = zconv; ldc = 3072; ct = pn * 256; }
        else if (pn < 15) { dst = zq; ldc = 768; ct = (pn - 12) * 256; }
        else if (pn < 17) { dst = zkv; ldc = 512; ct = (pn - 15) * 256; }
        else if (pn < 33) { dst = zg; ldc = 4096; ct = (pn - 17) * 256; mode = 1; }
        else { dst = zkr; ldc = 64; ct = 0; mode = 2; }
        const int row0 = u.pm * BM + wr * 64 + fr, c0 = wc * 32 + 8 * fq;
        const f32x4 zero4 = (f32x4){0.f, 0.f, 0.f, 0.f};
        f32x4 bias[2][2] = {{zero4, zero4}, {zero4, zero4}};
        if (mode == 1) {
#pragma unroll
            for (int bj = 0; bj < 2; ++bj) { bias[bj][0] = *(const f32x4*)(bgate + ct + c0 + bj * HALF); bias[bj][1] = *(const f32x4*)(bgate + ct + c0 + bj * HALF + 4); }
        }
#pragma unroll
        for (int bj = 0; bj < 2; ++bj) {
            const int c = c0 + bj * HALF;
            if (mode == 2 && c >= 64) continue;
            const f32x4 b0 = bias[bj][0], b1 = bias[bj][1];
#pragma unroll
            for (int ai = 0; ai < 2; ++ai)
#pragma unroll
                for (int m = 0; m < 4; ++m) {
                    f32x4 v0 = acc[ai][bj][m][0] + b0, v1 = acc[ai][bj][m][1] + b1;
                    if (mode == 1) {
#pragma unroll
                        for (int e = 0; e < 4; ++e) { v0[e] = sigmoid_f(v0[e]); v1[e] = sigmoid_f(v1[e]); }
                    }
                    u32x4 w; w.x = cvt_pk_bf16(v0[0], v0[1]); w.y = cvt_pk_bf16(v0[2], v0[3]); w.z = cvt_pk_bf16(v1[0], v1[1]); w.w = cvt_pk_bf16(v1[2], v1[3]);
                    *(u32x4*)(dst + (size_t)(row0 + ai * HALF + m * 16) * ldc + ct + c) = w;
                }
        }
    }
};
struct EpiFma {
    static constexpr bool PERM = true, AFTER_DRAIN = false;
    bf16_t* O; int ldc; const bf16_t* mul; int ldmul, mcol; const bf16_t* add; int ldadd;
    __device__ __forceinline__ void operator()(const f32x4 (&acc)[2][2][4][2], const Unit& u, int wr, int wc, int fr, int fq) const {
        const int row0 = u.pm * BM + wr * 64 + fr, c0 = u.pn * BM + wc * 32 + 8 * fq;
#pragma unroll
        for (int ai = 0; ai < 2; ++ai) {
            u32x4 gv[4][2], av[4][2];
#pragma unroll
            for (int m = 0; m < 4; ++m)
#pragma unroll
                for (int bj = 0; bj < 2; ++bj) { const size_t row = (size_t)(row0 + ai * HALF + m * 16); const int c = c0 + bj * HALF;
                    gv[m][bj] = *(const u32x4*)(mul + row * ldmul + mcol + c);
                    av[m][bj] = add ? *(const u32x4*)(add + row * ldadd + c) : (u32x4){0u, 0u, 0u, 0u}; }
#pragma unroll
            for (int m = 0; m < 4; ++m) {
                const size_t row = (size_t)(row0 + ai * HALF + m * 16);
#pragma unroll
                for (int bj = 0; bj < 2; ++bj) {
                    const int c = c0 + bj * HALF;
                    const u32x4 g = gv[m][bj], a = av[m][bj];
                    f32x4 v0 = acc[ai][bj][m][0], v1 = acc[ai][bj][m][1];
                    v0[0] = v0[0] * bf_lo(g.x) + bf_lo(a.x); v0[1] = v0[1] * bf_hi(g.x) + bf_hi(a.x); v0[2] = v0[2] * bf_lo(g.y) + bf_lo(a.y); v0[3] = v0[3] * bf_hi(g.y) + bf_hi(a.y);
                    v1[0] = v1[0] * bf_lo(g.z) + bf_lo(a.z); v1[1] = v1[1] * bf_hi(g.z) + bf_hi(a.z); v1[2] = v1[2] * bf_lo(g.w) + bf_lo(a.w); v1[3] = v1[3] * bf_hi(g.w) + bf_hi(a.w);
                    u32x4 w; w.x = cvt_pk_bf16(v0[0], v0[1]); w.y = cvt_pk_bf16(v0[2], v0[3]); w.z = cvt_pk_bf16(v1[0], v1[1]); w.w = cvt_pk_bf16(v1[2], v1[3]);
                    *(u32x4*)(O + row * ldc + c) = w;
                }
            }
        }
    }
};
struct EpiResF32 {
    static constexpr bool PERM = false, AFTER_DRAIN = false;
    const float* base; float* out; int ldc; bool nt_store;
    __device__ __forceinline__ void operator()(const f32x4 (&acc)[2][2][4][2], const Unit& u, int wr, int wc, int fr, int fq) const {
        const int row0 = u.pm * BM + wr * 64 + fr, c0 = u.pn * BM + wc * 32 + 4 * fq;
#pragma unroll
        for (int ai = 0; ai < 2; ++ai) {
            f32x4 b[4][2][2];
#pragma unroll
            for (int m = 0; m < 4; ++m)
#pragma unroll
                for (int bj = 0; bj < 2; ++bj)
#pragma unroll
                    for (int n = 0; n < 2; ++n) b[m][bj][n] = __builtin_nontemporal_load((const f32x4*)(base + (size_t)(row0 + ai * HALF + m * 16) * ldc + c0 + bj * HALF + n * 16));
#pragma unroll
            for (int m = 0; m < 4; ++m) {
                const size_t off = (size_t)(row0 + ai * HALF + m * 16) * ldc + c0;
#pragma unroll
                for (int bj = 0; bj < 2; ++bj)
#pragma unroll
                    for (int n = 0; n < 2; ++n) {
                        if (nt_store) __builtin_nontemporal_store(b[m][bj][n] + acc[ai][bj][m][n], (f32x4*)(out + off + bj * HALF + n * 16));
                        else *(f32x4*)(out + off + bj * HALF + n * 16) = b[m][bj][n] + acc[ai][bj][m][n]; }
            }
        }
    }
};

typedef unsigned u32x2 __attribute__((ext_vector_type(2)));

struct EpiQ {
    static constexpr bool PERM = true, AFTER_DRAIN = false;
    bf16_t* qf; const float* gq; const float* cst; const float* snt; PG8_LAS float* part;
    __device__ __forceinline__ void operator()(const f32x4 (&acc)[2][2][4][2], const Unit& u, int wr, int wc, int fr, int fq) const {
        const int h = u.pn, row0 = u.pm * BM + wr * 64 + fr; const bool ropew = wc < 2;
#pragma unroll
        for (int ai = 0; ai < 2; ++ai)
#pragma unroll
            for (int m = 0; m < 4; ++m) { float s = 0.f;
#pragma unroll
                for (int n = 0; n < 2; ++n) { const f32x4 x = acc[ai][0][m][n]; s += (x[0] * x[0] + x[1] * x[1]) + (x[2] * x[2] + x[3] * x[3]);
                    if (ropew) { const f32x4 y = acc[ai][1][m][n]; s += (y[0] * y[0] + y[1] * y[1]) + (y[2] * y[2] + y[3] * y[3]); } }
                s = sum_rows4(s);
                if (fq == 0) part[(wr * 4 + wc) * 128 + ai * 64 + m * 16 + fr] = s; }
        asm volatile("s_waitcnt lgkmcnt(0)" ::: "memory"); __builtin_amdgcn_s_barrier(); asm volatile("" ::: "memory");
        const int cn = 32 * wc + 8 * fq, i0 = ropew ? 16 * wc + 4 * fq : 0;
        const f32x4 g0 = *(const f32x4*)(gq + cn), g1 = *(const f32x4*)(gq + cn + 4), gr1 = *(const f32x4*)(gq + 128 + i0), gr2 = *(const f32x4*)(gq + 160 + i0);
#pragma unroll
        for (int ai = 0; ai < 2; ++ai) {
            f32x4 cv[4], sv[4];
            if (ropew) {
#pragma unroll
                for (int m = 0; m < 4; ++m) { const size_t row = (size_t)(row0 + ai * HALF + m * 16); cv[m] = *(const f32x4*)(cst + row * 32 + i0); sv[m] = *(const f32x4*)(snt + row * 32 + i0); }
            }
#pragma unroll
            for (int m = 0; m < 4; ++m) { const int r128 = ai * 64 + m * 16 + fr;
                const float tot = (part[(wr * 4 + 0) * 128 + r128] + part[(wr * 4 + 1) * 128 + r128]) + (part[(wr * 4 + 2) * 128 + r128] + part[(wr * 4 + 3) * 128 + r128]);
                const float rq = rsqrtf(tot * (1.f / 192.f) + 1e-6f);
                const size_t row = (size_t)(row0 + ai * HALF + m * 16); bf16_t* qrow = qf + row * 3072 + h * 192;
                const f32x4 v0 = acc[ai][0][m][0] * rq * g0, v1 = acc[ai][0][m][1] * rq * g1;
                u32x4 w; w.x = cvt_pk_bf16(v0[0], v0[1]); w.y = cvt_pk_bf16(v0[2], v0[3]); w.z = cvt_pk_bf16(v1[0], v1[1]); w.w = cvt_pk_bf16(v1[2], v1[3]);
                *(u32x4*)(qrow + cn) = w;
                if (ropew) { const f32x4 x1 = acc[ai][1][m][0] * rq * gr1, x2 = acc[ai][1][m][1] * rq * gr2;
                    const f32x4 c4 = cv[m], s4 = sv[m];
                    const f32x4 o1 = x1 * c4 - x2 * s4, o2 = x2 * c4 + x1 * s4;
                    u32x2 a; a.x = cvt_pk_bf16(o1[0], o1[1]); a.y = cvt_pk_bf16(o1[2], o1[3]); *(u32x2*)(qrow + 128 + i0) = a;
                    u32x2 b; b.x = cvt_pk_bf16(o2[0], o2[1]); b.y = cvt_pk_bf16(o2[2], o2[3]); *(u32x2*)(qrow + 160 + i0) = b; }
            }
        }
    }
};
struct EpiKV {
    static constexpr bool PERM = true, AFTER_DRAIN = false;
    bf16_t* kf; bf16_t* vdst; const float* gk; const float* krr; const float* krss; PG8_LAS float* part;
    __device__ __forceinline__ void operator()(const f32x4 (&acc)[2][2][4][2], const Unit& u, int wr, int wc, int fr, int fq) const {
        const int h = u.pn, row0 = u.pm * BM + wr * 64 + fr;
#pragma unroll
        for (int ai = 0; ai < 2; ++ai)
#pragma unroll
            for (int m = 0; m < 4; ++m) { float s = 0.f;
#pragma unroll
                for (int n = 0; n < 2; ++n) { const f32x4 x = acc[ai][0][m][n]; s += (x[0] * x[0] + x[1] * x[1]) + (x[2] * x[2] + x[3] * x[3]); }
                s = sum_rows4(s);
                if (fq == 0) part[(wr * 4 + wc) * 128 + ai * 64 + m * 16 + fr] = s; }
        asm volatile("s_waitcnt lgkmcnt(0)" ::: "memory"); __builtin_amdgcn_s_barrier(); asm volatile("" ::: "memory");
        const int cn = 32 * wc + 8 * fq, i0 = 16 * wc + 4 * fq;
        const f32x4 g0 = *(const f32x4*)(gk + cn), g1 = *(const f32x4*)(gk + cn + 4);
        f32x4 krv[2][4]; float kss[2][4];
#pragma unroll
        for (int ai = 0; ai < 2; ++ai)
#pragma unroll
            for (int m = 0; m < 4; ++m) { const size_t row = (size_t)(row0 + ai * HALF + m * 16); krv[ai][m] = *(const f32x4*)(krr + row * 64 + i0); kss[ai][m] = krss[row]; }
#pragma unroll
        for (int ai = 0; ai < 2; ++ai)
#pragma unroll
            for (int m = 0; m < 4; ++m) { const int r128 = ai * 64 + m * 16 + fr;
                const size_t row = (size_t)(row0 + ai * HALF + m * 16);
                const float tot = (part[(wr * 4 + 0) * 128 + r128] + part[(wr * 4 + 1) * 128 + r128]) + (part[(wr * 4 + 2) * 128 + r128] + part[(wr * 4 + 3) * 128 + r128]) + kss[ai][m];
                const float rk = rsqrtf(tot * (1.f / 192.f) + 1e-6f);
                bf16_t* krow = kf + row * 3072 + h * 192;
                const f32x4 v0 = acc[ai][0][m][0] * rk * g0, v1 = acc[ai][0][m][1] * rk * g1;
                u32x4 w; w.x = cvt_pk_bf16(v0[0], v0[1]); w.y = cvt_pk_bf16(v0[2], v0[3]); w.z = cvt_pk_bf16(v1[0], v1[1]); w.w = cvt_pk_bf16(v1[2], v1[3]);
                *(u32x4*)(krow + cn) = w;
                const f32x4 kr4 = krv[ai][m] * rk;
                u32x2 a; a.x = cvt_pk_bf16(kr4[0], kr4[1]); a.y = cvt_pk_bf16(kr4[2], kr4[3]); *(u32x2*)(krow + 128 + i0) = a;
                const f32x4 y0 = acc[ai][1][m][0], y1 = acc[ai][1][m][1];
                u32x4 z; z.x = cvt_pk_bf16(y0[0], y0[1]); z.y = cvt_pk_bf16(y0[2], y0[3]); z.z = cvt_pk_bf16(y1[0], y1[1]); z.w = cvt_pk_bf16(y1[2], y1[3]);
                *(u32x4*)(vdst + row * 4096 + h * 256 + 128 + cn) = z;
            }
    }
};
struct EpiResNorm {
    static constexpr bool PERM = false, AFTER_DRAIN = false;
    const float* base; float* out; bf16_t* hb; float* rowss; int ldc;
    __device__ __forceinline__ void operator()(const f32x4 (&acc)[2][2][4][2], const Unit& u, int wr, int wc, int fr, int fq) const {
        const int row0 = u.pm * BM + wr * 64 + fr, c0 = u.pn * BM + wc * 32 + 4 * fq;
#pragma unroll
        for (int ai = 0; ai < 2; ++ai) {
            f32x4 b[4][2][2];
#pragma unroll
            for (int m = 0; m < 4; ++m)
#pragma unroll
                for (int bj = 0; bj < 2; ++bj)
#pragma unroll
                    for (int n = 0; n < 2; ++n) b[m][bj][n] = __builtin_nontemporal_load((const f32x4*)(base + (size_t)(row0 + ai * HALF + m * 16) * ldc + c0 + bj * HALF + n * 16));
#pragma unroll
            for (int m = 0; m < 4; ++m) {
                const int row = row0 + ai * HALF + m * 16; const size_t off = (size_t)row * ldc + c0; float ss = 0.f;
#pragma unroll
                for (int bj = 0; bj < 2; ++bj)
#pragma unroll
                    for (int n = 0; n < 2; ++n) { const f32x4 h = b[m][bj][n] + acc[ai][bj][m][n];
                        *(f32x4*)(out + off + bj * HALF + n * 16) = h; ss += (h[0] * h[0] + h[1] * h[1]) + (h[2] * h[2] + h[3] * h[3]);
                        u32x2 w; w.x = cvt_pk_bf16(h[0], h[1]); w.y = cvt_pk_bf16(h[2], h[3]); *(u32x2*)(hb + off + bj * HALF + n * 16) = w; }
                ss = sum_rows4(ss);
                if (fq == 0) unsafeAtomicAdd(rowss + row, ss);
            }
        }
    }
};
__device__ __forceinline__ float dpp_ror1(float v) { return __builtin_bit_cast(float, __builtin_amdgcn_update_dpp(0, __builtin_bit_cast(int, v), 0x121, 0xf, 0xf, false)); }
__device__ __forceinline__ float dpp_ror2(float v) { return __builtin_bit_cast(float, __builtin_amdgcn_update_dpp(0, __builtin_bit_cast(int, v), 0x122, 0xf, 0xf, false)); }
__device__ __forceinline__ float fma_s(float a, float b, float c) { float r; asm("v_fma_f32 %0, %1, %2, %3" : "=v"(r) : "v"(a), "v"(b), "v"(c)); return r; }
struct EpiUpGate {
    static constexpr bool PERM = true, AFTER_DRAIN = false;
    bf16_t* gout; const float* fw; const float* fb; PG8_LAS float* xch; const float* rowss;
    __device__ __forceinline__ void operator()(const f32x4 (&acc)[2][2][4][2], const Unit& u, int wr, int wc, int fr, int fq) const {
        constexpr int FF = 5632;
        const int b = u.pm / 17, ti = u.pm % 17, t0 = 254 * ti - 2;
        const int colx = wc * 32 + fq * 8, j0 = u.pn * 128 + colx;
        float r2v[2][4]; f32x4 wts[2][2][4];
#pragma unroll
        for (int ai = 0; ai < 2; ++ai)
#pragma unroll
            for (int m = 0; m < 4; ++m) { int t = t0 + ai * HALF + wr * 64 + m * 16 + fr; t = t < 0 ? 0 : (t > 4095 ? 4095 : t); r2v[ai][m] = rowss[b * 4096 + t]; }
#pragma unroll
        for (int bj = 0; bj < 2; ++bj) { const int c = bj * FF + j0;
            wts[0][bj][0] = *(const f32x4*)(fw + c); wts[0][bj][1] = *(const f32x4*)(fw + 2 * FF + c); wts[0][bj][2] = *(const f32x4*)(fw + 4 * FF + c); wts[0][bj][3] = *(const f32x4*)(fb + c); }
#pragma unroll
        for (int ai = 0; ai < 2; ++ai)
#pragma unroll
            for (int m = 0; m < 4; ++m) r2v[ai][m] = rsqrtf(r2v[ai][m] * (1.f / 2048.f) + 1e-6f);
        if (fr >= 14) {
#pragma unroll
            for (int ai = 0; ai < 2; ++ai)
#pragma unroll
                for (int bj = 0; bj < 2; ++bj)
#pragma unroll
                    for (int n = 0; n < 2; ++n) *(PG8_LAS f32x4*)(xch + (((ai * 2 + wr) * 2 + (fr - 14)) * 256 + bj * 128 + colx + n * 4)) = acc[ai][bj][3][n] * r2v[ai][3];
        }
        asm volatile("s_waitcnt lgkmcnt(0)" ::: "memory"); __builtin_amdgcn_s_barrier(); asm volatile("" ::: "memory");
        const bool first = (ti == 0);
        const f32x4 zero4 = (f32x4){0.f, 0.f, 0.f, 0.f};
#pragma unroll
        for (int n = 0; n < 2; ++n) {
            const f32x4 w0[2] = {wts[n][0][0], wts[n][1][0]}, w1[2] = {wts[n][0][1], wts[n][1][1]}, w2[2] = {wts[n][0][2], wts[n][1][2]}, bb[2] = {wts[n][0][3], wts[n][1][3]};
#pragma unroll
            for (int ai = 0; ai < 2; ++ai) {
                f32x4 pr1[2] = {zero4, zero4}, pr2[2] = {zero4, zero4};
                const bool hasprev = (wr == 1) || (ai == 1);
                const int pg = (wr == 1) ? ai * 2 : (ai - 1) * 2 + 1;
                if (hasprev && fr < 2) {
#pragma unroll
                    for (int bj = 0; bj < 2; ++bj) {
                        pr2[bj] = *(const PG8_LAS f32x4*)(xch + ((pg * 2 + fr) * 256 + bj * 128 + colx + n * 4));
                        pr1[bj] = *(const PG8_LAS f32x4*)(xch + ((pg * 2 + 1) * 256 + bj * 128 + colx + n * 4)); }
                }
#pragma unroll
                for (int m = 0; m < 4; ++m) {
                    f32x4 cur[2] = {acc[ai][0][m][n] * r2v[ai][m], acc[ai][1][m][n] * r2v[ai][m]};
                    if (first && ai == 0 && wr == 0 && m == 0 && fr < 2) { cur[0] = zero4; cur[1] = zero4; }
                    f32x4 r1[2], r2[2], av[2];
#pragma unroll
                    for (int bj = 0; bj < 2; ++bj)
#pragma unroll
                        for (int e = 0; e < 4; ++e) { r1[bj][e] = dpp_ror1(cur[bj][e]); r2[bj][e] = dpp_ror2(cur[bj][e]); }
#pragma unroll
                    for (int bj = 0; bj < 2; ++bj)
#pragma unroll
                        for (int e = 0; e < 4; ++e) { const float p1 = fr >= 1 ? r1[bj][e] : pr1[bj][e], p2 = fr >= 2 ? r2[bj][e] : pr2[bj][e];
                            av[bj][e] = fma_s(w0[bj][e], p2, fma_s(w1[bj][e], p1, fma_s(w2[bj][e], cur[bj][e], bb[bj][e]))); }
                    float o[4];
#pragma unroll
                    for (int e = 0; e < 4; ++e) o[e] = av[0][e] * sigmoid_f(av[0][e]) * av[1][e];
                    const int lr = ai * HALF + wr * 64 + m * 16 + fr, t = t0 + lr;
                    if (lr >= 2 && t < 4096) { u32x2 w; w.x = cvt_pk_bf16(o[0], o[1]); w.y = cvt_pk_bf16(o[2], o[3]);
                        *(u32x2*)(gout + (size_t)(b * 4096 + t) * FF + j0 + n * 4) = w; }
                    pr1[0] = r1[0]; pr1[1] = r1[1]; pr2[0] = r2[0]; pr2[1] = r2[1];
                }
                if (n == 0 && ai == 0) {
#pragma unroll
                    for (int bj = 0; bj < 2; ++bj) { const int c = bj * FF + j0 + 4;
                        wts[1][bj][0] = *(const f32x4*)(fw + c); wts[1][bj][1] = *(const f32x4*)(fw + 2 * FF + c); wts[1][bj][2] = *(const f32x4*)(fw + 4 * FF + c); wts[1][bj][3] = *(const f32x4*)(fb + c); }
                }
            }
        }
    }
};
template <class Epi, class Sched, bool ALIGN_EPI = false, bool SP2 = false>
__device__ __forceinline__ void gemm_phase(PG8_LAS unsigned char* lds, const Gemm g, const Sched& S, const Epi& E) {
    int tid_ = threadIdx.x; asm volatile("" : "+v"(tid_));
    const int tid = tid_, wid = __builtin_amdgcn_readfirstlane(tid >> 6), lane = tid & 63, wr = wid >> 2, wc = wid & 3, fr = lane & 15, fq = lane >> 4;
    const int K = g.K, nt = K / BK;
    unsigned voffA[2], voffB[2];
#pragma unroll
    for (int i = 0; i < 2; ++i) { int R, C; stage_rc(tid * 16 + i * 8192, R, C); const int Rb = Epi::PERM ? ((R & ~31) + perm32(R & 31)) : R;
        voffA[i] = (unsigned)(R * K + C) * 2u; voffB[i] = (unsigned)(Rb * K + C) * 2u; }
    const size_t kstep = (size_t)(BK * 2);
    const size_t hstep = (size_t)HALF * K * 2;
    const size_t tstep = 2 * hstep;
    const unsigned ldsw = (unsigned)wid * 1024u;
    const int aoff = lds_byte(wr * 64 + fr, fq * 8), boff = lds_byte(wc * 32 + fr, fq * 8);
#define PG8_SA(b, h) (((b) * 2 + (h)) * HTB)
#define PG8_SB(b, h) ((4 + (b) * 2 + (h)) * HTB)
#define PG8_STAGE(bufoff, gbase, voff) do { _Pragma("unroll") for (int _i = 0; _i < 2; ++_i) \
        __builtin_amdgcn_global_load_lds((const unsigned*)((const char*)(gbase) + (voff)[_i]), (PG8_LAS unsigned*)(lds + (bufoff) + ldsw + _i * 8192), 16, 0, 0); } while (0)
#define PG8_LDA(dst, b, h) do { _Pragma("unroll") for (int m = 0; m < 4; ++m) _Pragma("unroll") for (int k = 0; k < 2; ++k) dst[m][k] = *(const PG8_LAS bf16x8*)(lds + PG8_SA(b, h) + aoff + m * 2048 + k * 1024); } while (0)
#define PG8_LDB(dst, b, h) do { _Pragma("unroll") for (int n = 0; n < 2; ++n) _Pragma("unroll") for (int k = 0; k < 2; ++k) dst[n][k] = *(const PG8_LAS bf16x8*)(lds + PG8_SB(b, h) + boff + n * 2048 + k * 1024); } while (0)
#define PG8_MMA(ai, bj, At, Bt) do { __builtin_amdgcn_s_setprio(1); _Pragma("unroll") for (int m = 0; m < 4; ++m) _Pragma("unroll") for (int n = 0; n < 2; ++n) _Pragma("unroll") for (int k = 0; k < 2; ++k) \
        acc[ai][bj][m][n] = __builtin_amdgcn_mfma_f32_16x16x32_bf16(Bt[n][k], At[m][k], acc[ai][bj][m][n], 0, 0, 0); __builtin_amdgcn_s_setprio(0); } while (0)
#define PG8_WAIT_V(n) asm volatile("s_waitcnt vmcnt(" #n ")" ::: "memory")
#define PG8_WAIT_L(n) asm volatile("s_waitcnt lgkmcnt(" #n ")" ::: "memory")
#define PG8_BAR __builtin_amdgcn_s_barrier()
#define PG8_SCHED __builtin_amdgcn_sched_barrier(0)
    Unit cur, nxt; int ui = 0;
    if (!S.next(0, cur)) return;
    f32x4 acc[2][2][4][2];
#pragma unroll
    for (int a = 0; a < 2; ++a)
#pragma unroll
        for (int b = 0; b < 2; ++b)
#pragma unroll
            for (int m = 0; m < 4; ++m)
#pragma unroll
                for (int n = 0; n < 2; ++n) acc[a][b][m][n] = (f32x4){0.f, 0.f, 0.f, 0.f};
    bf16x8 At[4][2], B0[2][2], B1[2][2];
    const char* cA = (const char*)g.A + (long)S.a_row(cur) * (long)(K * 2); const char* cB = (const char*)g.Bt + (size_t)cur.pn * tstep;
    S.a_ready(cur);
    if constexpr (SP2) {
        PG8_STAGE(PG8_SB(0, 0), cB, voffB); PG8_STAGE(PG8_SB(0, 1), cB + hstep, voffB); PG8_STAGE(PG8_SA(0, 0), cA, voffA); PG8_STAGE(PG8_SA(0, 1), cA + hstep, voffA);
        if (wr == 1) PG8_BAR;
        PG8_WAIT_V(2); PG8_BAR;
        PG8_STAGE(PG8_SB(1, 0), cB + kstep, voffB); PG8_STAGE(PG8_SA(1, 0), cA + kstep, voffA); PG8_STAGE(PG8_SB(1, 1), cB + hstep + kstep, voffB);
        PG8_WAIT_V(6); PG8_BAR;
    } else {
        PG8_STAGE(PG8_SB(0, 0), cB, voffB); PG8_STAGE(PG8_SA(0, 0), cA, voffA); PG8_STAGE(PG8_SB(0, 1), cB + hstep, voffB); PG8_STAGE(PG8_SA(0, 1), cA + hstep, voffA);
        if (wr == 1) PG8_BAR;
        PG8_WAIT_V(4); PG8_BAR;
        PG8_STAGE(PG8_SB(1, 0), cB + kstep, voffB); PG8_STAGE(PG8_SA(1, 0), cA + kstep, voffA); PG8_STAGE(PG8_SB(1, 1), cB + hstep + kstep, voffB);
        PG8_WAIT_V(6); PG8_BAR;
    }
    for (;;) {
        const bool has_next = S.next(ui + 1, nxt);
        const char* nA = has_next ? (const char*)g.A + (long)S.a_row(nxt) * (long)(K * 2) : cA; const char* nB = has_next ? (const char*)g.Bt + (size_t)nxt.pn * tstep : cB;
        for (int t = 0; t < nt; t += 2) {
            const bool last = (t == nt - 2);
            const char* a1 = cA + (size_t)(t + 1) * kstep;
            const char* a2 = last ? nA : cA + (size_t)(t + 2) * kstep; const char* b2 = last ? nB : cB + (size_t)(t + 2) * kstep;
            const char* a3 = a2 + kstep; const char* b3 = b2 + kstep;
            if (last && has_next) S.a_ready(nxt);
            if constexpr (SP2) {
            PG8_LDB(B0, 0, 0); PG8_LDB(B1, 0, 1); PG8_SCHED; PG8_LDA(At, 0, 0); PG8_STAGE(PG8_SA(1, 1), a1 + hstep, voffA);
            PG8_WAIT_V(8); PG8_WAIT_L(0); PG8_BAR; PG8_MMA(0, 0, At, B0); PG8_MMA(0, 1, At, B1); PG8_BAR; PG8_SCHED;
            PG8_LDA(At, 0, 1); PG8_STAGE(PG8_SB(0, 0), b2, voffB); PG8_STAGE(PG8_SB(0, 1), b2 + hstep, voffB); PG8_STAGE(PG8_SA(0, 0), a2, voffA);
            PG8_WAIT_V(8); PG8_WAIT_L(0); PG8_BAR; PG8_MMA(1, 0, At, B0); PG8_MMA(1, 1, At, B1); PG8_BAR; PG8_SCHED;
            PG8_LDB(B0, 1, 0); PG8_LDB(B1, 1, 1); PG8_SCHED; PG8_LDA(At, 1, 0); PG8_STAGE(PG8_SA(0, 1), a2 + hstep, voffA);
            PG8_WAIT_V(8); PG8_WAIT_L(0); PG8_BAR; PG8_MMA(0, 0, At, B0); PG8_MMA(0, 1, At, B1); PG8_BAR; PG8_SCHED;
            PG8_LDA(At, 1, 1); PG8_STAGE(PG8_SB(1, 0), b3, voffB); PG8_STAGE(PG8_SB(1, 1), b3 + hstep, voffB); PG8_STAGE(PG8_SA(1, 0), a3, voffA);
            PG8_WAIT_V(8); PG8_WAIT_L(0); PG8_BAR; PG8_MMA(1, 0, At, B0); PG8_MMA(1, 1, At, B1); PG8_BAR; PG8_SCHED;
            } else {
            PG8_LDB(B0, 0, 0); PG8_SCHED; PG8_LDA(At, 0, 0); PG8_STAGE(PG8_SA(1, 1), a1 + hstep, voffA);
            PG8_WAIT_L(8); PG8_BAR; PG8_WAIT_L(0); PG8_MMA(0, 0, At, B0); PG8_BAR; PG8_SCHED;
            PG8_LDB(B1, 0, 1); PG8_STAGE(PG8_SB(0, 0), b2, voffB);
            PG8_BAR; PG8_WAIT_L(0); PG8_MMA(0, 1, At, B1); PG8_BAR;
            PG8_LDA(At, 0, 1); PG8_STAGE(PG8_SA(0, 0), a2, voffA);
            PG8_BAR; PG8_WAIT_L(0); PG8_MMA(1, 0, At, B0); PG8_BAR; PG8_SCHED;
            PG8_STAGE(PG8_SB(0, 1), b2 + hstep, voffB);
            PG8_WAIT_V(6); PG8_BAR; PG8_MMA(1, 1, At, B1); PG8_BAR;
            PG8_LDB(B0, 1, 0); PG8_SCHED; PG8_LDA(At, 1, 0); PG8_STAGE(PG8_SA(0, 1), a2 + hstep, voffA);
            PG8_WAIT_L(8); PG8_BAR; PG8_WAIT_L(0); PG8_MMA(0, 0, At, B0); PG8_BAR; PG8_SCHED;
            PG8_LDB(B1, 1, 1); PG8_STAGE(PG8_SB(1, 0), b3, voffB);
            PG8_BAR; PG8_WAIT_L(0); PG8_MMA(0, 1, At, B1); PG8_BAR;
            PG8_LDA(At, 1, 1); PG8_STAGE(PG8_SA(1, 0), a3, voffA);
            PG8_BAR; PG8_WAIT_L(0); PG8_MMA(1, 0, At, B0); PG8_BAR; PG8_SCHED;
            PG8_STAGE(PG8_SB(1, 1), b3 + hstep, voffB);
            PG8_WAIT_V(6); PG8_BAR; PG8_MMA(1, 1, At, B1); PG8_BAR;
            }
        }
        if constexpr (ALIGN_EPI) { if (wr == 0) PG8_BAR; }
        if constexpr (!Epi::AFTER_DRAIN) { E(acc, cur, wr, wc, fr, fq); S.done(cur); }
        if (!has_next) break;
#pragma unroll
        for (int a = 0; a < 2; ++a)
#pragma unroll
            for (int b = 0; b < 2; ++b)
#pragma unroll
                for (int m = 0; m < 4; ++m)
#pragma unroll
                    for (int n = 0; n < 2; ++n) acc[a][b][m][n] = (f32x4){0.f, 0.f, 0.f, 0.f};
        cur = nxt; cA = nA; cB = nB; ++ui;
        if constexpr (ALIGN_EPI) { if (wr == 1) PG8_BAR; }
    }
    PG8_WAIT_V(0);
    if constexpr (!ALIGN_EPI) { if (wr == 0) PG8_BAR; }
    PG8_BAR;
    if constexpr (Epi::AFTER_DRAIN) { E.fused(acc, cur, wr, wc, fr, fq, lds, wid, lane); S.done(cur); }
#undef PG8_SA
#undef PG8_SB
#undef PG8_STAGE
#undef PG8_LDA
#undef PG8_LDB
#undef PG8_MMA
#undef PG8_WAIT_V
#undef PG8_WAIT_L
#undef PG8_BAR
#undef PG8_SCHED
}
}
namespace att {
using bf16 = __hip_bfloat16;
typedef short bf16x8 __attribute__((ext_vector_type(8)));
typedef short s16x4 __attribute__((ext_vector_type(4)));
typedef float f32x16 __attribute__((ext_vector_type(16)));
typedef float f32x4 __attribute__((ext_vector_type(4)));
typedef unsigned u32x4 __attribute__((ext_vector_type(4)));
constexpr int DK = 192, DV = 128;
constexpr int QS = 3072, KS = 3072, VS = 4096, OS = 2048;
constexpr int SEQ = 4096, NH = 16;
constexpr float SCALE = 0.07216878364870322f;
constexpr float THR = 8.f;
constexpr int NW = 8, QBLK = 32, KVBLK = 64, QB = NW * QBLK;
constexpr int SHM_V = KVBLK * DV * 2, SHM_K = KVBLK * DK * 2;
constexpr int LDS_Q = 2 * SHM_V + 2 * SHM_K + NW * 64 * 4;
constexpr int NQR = 6, NQL_ = 12 - NQR;
constexpr int LDS_BYTES = LDS_Q + NW * NQL_ * 64 * 16;
#define KSWZ(row, colB) ((row) * 384 + ((colB) ^ ((((row) >> 1) & 7) << 4)))
#define SBAR() __builtin_amdgcn_sched_barrier(0)
__device__ __forceinline__ int v_st(int k, int c) { const int kk = (k & ~0xC) | ((k & 4) << 1) | ((k & 8) >> 1); return ((kk >> 3) * 4 + (c >> 5)) * 512 + ((kk & 7) * 32 + (c & 31)) * 2; }
__device__ __forceinline__ int v_rd_base(int lane) { return ((lane & 3) << 3) | (((lane >> 2) & 3) << 6) | (((lane >> 4) & 1) << 5) | (((lane >> 5) & 1) << 8); }
constexpr int v_rd_off(int d0, int ks, int half) { return d0 * 512 + ks * 4096 + half * 2048; }
__device__ __forceinline__ int crow(int r, int hi) { return (r & 3) + 8 * (r >> 2) + 4 * hi; }
__device__ __forceinline__ unsigned cvtpk(float lo, float hi) { unsigned r; asm volatile("v_cvt_pk_bf16_f32 %0, %1, %2" : "=v"(r) : "v"(lo), "v"(hi)); return r; }
__device__ __forceinline__ bf16x8 load8(const bf16* p) { return *reinterpret_cast<const bf16x8*>(p); }
__device__ __forceinline__ void mask_tile(f32x16& p0, f32x16& p1, int dq, unsigned W) {
    const float NEG = -__builtin_inff();
#pragma unroll
    for (int r = 0; r < 16; ++r) {
        const int c = (r & 3) + 8 * (r >> 2);
        if ((unsigned)(dq - c) >= W) p0[r] = NEG;
        if ((unsigned)(dq - c - 32) >= W) p1[r] = NEG;
    }
}
__device__ __forceinline__ void partialSM(f32x16& p0, f32x16& p1, float& m_reg, float& mn, float& alpha) {
    float pmax = p0[0]; for (int r = 1; r < 16; ++r) pmax = fmaxf(pmax, p0[r]); for (int r = 0; r < 16; ++r) pmax = fmaxf(pmax, p1[r]);
    { auto rr = __builtin_amdgcn_permlane32_swap(__float_as_uint(pmax), __float_as_uint(pmax), false, false);
      pmax = fmaxf(__uint_as_float(rr[0]), __uint_as_float(rr[1])); }
    constexpr float C2 = 1.4426950408889634f * SCALE;
    if (__builtin_expect(__all((pmax - m_reg) * SCALE <= THR), 1)) { mn = m_reg; alpha = 1.f; }
    else { mn = fmaxf(m_reg, pmax); alpha = __builtin_amdgcn_exp2f((m_reg - mn) * C2); m_reg = mn; }
    const float mnL = -mn * C2;
    for (int r = 0; r < 16; ++r) p0[r] = fmaf(p0[r], C2, mnL); for (int r = 0; r < 16; ++r) p1[r] = fmaf(p1[r], C2, mnL);
    for (int r = 0; r < 16; ++r) p0[r] = __builtin_amdgcn_exp2f(p0[r]);
}
__device__ __forceinline__ void finishSM(f32x16& p0, f32x16& p1, float alpha, float& l_reg, bf16x8& pa0, bf16x8& pa1, bf16x8& pa2, bf16x8& pa3) {
    for (int r = 0; r < 16; ++r) p1[r] = __builtin_amdgcn_exp2f(p1[r]);
    float ps = 0; for (int r = 0; r < 16; ++r) ps += p0[r]; for (int r = 0; r < 16; ++r) ps += p1[r];
    { auto rr = __builtin_amdgcn_permlane32_swap(__float_as_uint(ps), __float_as_uint(ps), false, false);
      ps = __uint_as_float(rr[0]) + __uint_as_float(rr[1]); }
    l_reg = l_reg * alpha + ps;
#define PK4(P, B_, OUT) do { unsigned a0 = cvtpk(P[B_+0], P[B_+1]), a1 = cvtpk(P[B_+2], P[B_+3]);                          \
        unsigned b0 = cvtpk(P[B_+4], P[B_+5]), b1 = cvtpk(P[B_+6], P[B_+7]);                                             \
        auto r0 = __builtin_amdgcn_permlane32_swap(a0, b0, false, false); auto r1 = __builtin_amdgcn_permlane32_swap(a1, b1, false, false); \
        u32x4 w = {r0[0], r1[0], r0[1], r1[1]}; OUT = *reinterpret_cast<bf16x8*>(&w); } while (0)
    PK4(p0, 0, pa0); PK4(p0, 8, pa1); PK4(p1, 0, pa2); PK4(p1, 8, pa3);
#undef PK4
}
template <int KB>
__device__ __forceinline__ void qkt(f32x16& p0, f32x16& p1, const char* K_lds, int r32, int hi, const bf16x8* qr, const char* q_lds) {
    p0 = f32x16{}; p1 = f32x16{};
    const char* kb[4];
#pragma unroll
    for (int dd = 0; dd < 4; ++dd) kb[dd] = K_lds + KB * SHM_K + KSWZ(r32, (dd * 16 + hi * 8) * 2);
#pragma unroll
    for (int d0 = 0; d0 < 12; ++d0) { const char* a = kb[d0 & 3] + (d0 >> 2) * 128;
        bf16x8 b0 = *reinterpret_cast<const bf16x8*>(a);
        bf16x8 b1 = *reinterpret_cast<const bf16x8*>(a + 32 * 384);
        const bf16x8 qf = d0 < NQR ? qr[d0 < NQR ? d0 : 0] : *reinterpret_cast<const bf16x8*>(q_lds + (d0 - NQR) * 1024);
        p0 = __builtin_amdgcn_mfma_f32_32x32x16_bf16(b0, qf, p0, 0, 0, 0);
        p1 = __builtin_amdgcn_mfma_f32_32x32x16_bf16(b1, qf, p1, 0, 0, 0); }
}
template <int VB>
__device__ __forceinline__ void pv_tile(f32x16* o, int vb0, bf16x8 pa0, bf16x8 pa1, bf16x8 pa2, bf16x8 pa3) {
#define TRRD(dst, off) asm volatile("ds_read_b64_tr_b16 %0, %1 offset:%2" : "=&v"(dst) : "v"(vb0), "i"(off) : "memory")
#define PV_D0(d0) do { s16x4 l0, l1, l2, l3, h0, h1, h2, h3; constexpr int b_ = VB * SHM_V + v_rd_off(d0, 0, 0); \
        TRRD(l0, b_); TRRD(h0, b_ + 2048); TRRD(l1, b_ + 4096); TRRD(h1, b_ + 6144); TRRD(l2, b_ + 8192); TRRD(h2, b_ + 10240); TRRD(l3, b_ + 12288); TRRD(h3, b_ + 14336); \
        asm volatile("s_waitcnt lgkmcnt(0)" ::: "memory"); SBAR();   \
        o[d0] = __builtin_amdgcn_mfma_f32_32x32x16_bf16(pa0, (bf16x8){l0[0], l0[1], l0[2], l0[3], h0[0], h0[1], h0[2], h0[3]}, o[d0], 0, 0, 0);   \
        o[d0] = __builtin_amdgcn_mfma_f32_32x32x16_bf16(pa1, (bf16x8){l1[0], l1[1], l1[2], l1[3], h1[0], h1[1], h1[2], h1[3]}, o[d0], 0, 0, 0);   \
        o[d0] = __builtin_amdgcn_mfma_f32_32x32x16_bf16(pa2, (bf16x8){l2[0], l2[1], l2[2], l2[3], h2[0], h2[1], h2[2], h2[3]}, o[d0], 0, 0, 0);   \
        o[d0] = __builtin_amdgcn_mfma_f32_32x32x16_bf16(pa3, (bf16x8){l3[0], l3[1], l3[2], l3[3], h3[0], h3[1], h3[2], h3[3]}, o[d0], 0, 0, 0); } while (0)
    PV_D0(0); PV_D0(1); PV_D0(2); PV_D0(3);
#undef PV_D0
#undef TRRD
}
struct BlockRef { const bf16* Q; const bf16* K; const bf16* V; bf16* O; int P0; };
struct Seam { bf16x8 qr[NQR]; bf16x8 qt[NQL_]; bf16x8 st_v0, st_v1, st_k0, st_k1, st_k2; };
__device__ __forceinline__ int swa_jlo(int P0, int W) { const int lowk = P0 - W + 1; return lowk > 0 ? lowk / KVBLK : 0; }
#define VROW(p, k0, rr) ((p) + (size_t)((k0) + (rr)) * VS + sc)
#define KROW(p, k0) ((p) + (size_t)((k0) + kr_) * KS + kc_)
#define VMW() asm volatile("s_waitcnt vmcnt(0)" ::: "memory")
#define VMWN(n) asm volatile("s_waitcnt vmcnt(%0)" :: "i"(n) : "memory")
#define SLOAD_H(Kp, Vp, k0) do { S.st_v0 = load8(VROW(Vp, k0, sr)); S.st_v1 = load8(VROW(Vp, k0, 32 + sr));              \
                         S.st_k0 = load8(KROW(Kp, k0)); S.st_k1 = load8(KROW(Kp, k0) + 64); S.st_k2 = load8(KROW(Kp, k0) + 128); } while (0)
#define SWRITE_HK(bf) do { *(bf16x8*)(K_lds + (bf) * SHM_K + kws) = S.st_k0; *(bf16x8*)(K_lds + (bf) * SHM_K + kws + 128) = S.st_k1; *(bf16x8*)(K_lds + (bf) * SHM_K + kws + 256) = S.st_k2; } while (0)
#define SWRITE_HV(bf) do { *(bf16x8*)(V_lds + (bf) * SHM_V + vst0) = S.st_v0; *(bf16x8*)(V_lds + (bf) * SHM_V + vst1) = S.st_v1; } while (0)
#define SWRITE_H(bf) do { SWRITE_HV(bf); SWRITE_HK(bf); } while (0)
__device__ __forceinline__ void attn_prime(const BlockRef& cur, int W, char* lds, Seam& S) {
    int tid_ = threadIdx.x; asm volatile("" : "+v"(tid_));
    const int tid = tid_, wid = __builtin_amdgcn_readfirstlane(tid >> 6), lane = tid & 63, r32 = lane & 31, hi = lane >> 5;
    const int sr = tid >> 4, sc = (tid & 15) * 8, kr_ = tid >> 3, kc_ = (tid & 7) * 8, kws = KSWZ(kr_, kc_ * 2); char* K_lds = lds + 2 * SHM_V;
    const int kb0 = swa_jlo(cur.P0, W) * KVBLK;
#pragma unroll
    for (int d0 = 0; d0 < NQR; ++d0) S.qr[d0] = load8(cur.Q + (size_t)(wid * QBLK + r32) * QS + d0 * 16 + hi * 8);
#pragma unroll
    for (int d0 = 0; d0 < NQL_; ++d0) S.qt[d0] = load8(cur.Q + (size_t)(wid * QBLK + r32) * QS + (NQR + d0) * 16 + hi * 8);
    SLOAD_H(cur.K, cur.V, kb0); VMW(); SWRITE_HK(0);
    __syncthreads();
}
__device__ __forceinline__ void attn_block(const BlockRef& cur, const BlockRef& nxt, int skv, int W, char* lds, Seam& S) {
    int tid_ = threadIdx.x; asm volatile("" : "+v"(tid_));
    const int tid = tid_, wid = __builtin_amdgcn_readfirstlane(tid >> 6), lane = tid & 63, r32 = lane & 31, hi = lane >> 5;
    const int j_lo = swa_jlo(cur.P0, W);
    int j_hi = (cur.P0 + QB - 1) / KVBLK + 1; if (j_hi > skv / KVBLK) j_hi = skv / KVBLK;
    const int NT = j_hi - j_lo;
    const int kbn = swa_jlo(nxt.P0, W) * KVBLK;
    const int qlo = cur.P0 + wid * QBLK, qm = qlo + r32 - 4 * hi;
    char* V_lds = lds; char* K_lds = lds + 2 * SHM_V;
    float* ws = (float*)(lds + 2 * SHM_V + 2 * SHM_K) + wid * 64; float* li_l = ws, * al_l = ws + 32;
    float m_reg = -1e30f, l_reg = 0; f32x16 o[4] = {};
    const int sr = tid >> 4, sc = (tid & 15) * 8, vst0 = v_st(sr, sc), vst1 = v_st(32 + sr, sc);
    const int kr_ = tid >> 3, kc_ = (tid & 7) * 8, kws = KSWZ(kr_, kc_ * 2);
    const int vb0 = (int)(uintptr_t)V_lds + v_rd_base(lane);
    const bf16* Kh = cur.K; const bf16* Vh = cur.V;
#define RESC(a) do { if (__any((a) < 1.f)) { if (hi == 0) al_l[r32] = (a); asm volatile("s_waitcnt lgkmcnt(0)" ::: "memory");              \
                     for (int d_ = 0; d_ < 4; ++d_) for (int r = 0; r < 16; ++r) o[d_][r] *= al_l[crow(r, hi)]; } } while (0)
#define KBASE(t) ((j_lo + (t)) * KVBLK)
#define MASKT(P0_, P1_, t) do { const int kb_ = KBASE(t); if (kb_ + KVBLK - 1 > qlo || kb_ <= qlo + QBLK - 1 - W) mask_tile(P0_, P1_, qm - kb_, (unsigned)W); } while (0)
    constexpr int NQL = 12;
#define SEAM_K0() do { VMWN(NQL); SWRITE_HK(0); SBAR(); } while (0)
    f32x16 pA0, pA1, pB0, pB1; float mnA, mnB, alA, alB; bf16x8 pa0, pa1, pa2, pa3;
    char* q_lds = lds + LDS_Q + (wid * NQL_ * 64 + lane) * 16;
#pragma unroll
    for (int d0 = 0; d0 < NQL_; ++d0) *(bf16x8*)(q_lds + d0 * 1024) = S.qt[d0];
    SWRITE_HV(0); SBAR();
    if (NT > 1) { SLOAD_H(Kh, Vh, KBASE(1)); }
    SBAR(); qkt<0>(pA0, pA1, K_lds, r32, hi, S.qr, q_lds);
    MASKT(pA0, pA1, 0); partialSM(pA0, pA1, m_reg, mnA, alA);
    if (NT > 1) { VMW(); SWRITE_H(1); }
    __syncthreads();
#define HALF_STEP(PX0, PX1, mnX, alX, PY0, PY1, alY, t, KB, VB, SB) do {                                                      \
        SBAR(); qkt<KB>(PX0, PX1, K_lds, r32, hi, S.qr, q_lds);                                             \
        finishSM(PY0, PY1, alY, l_reg, pa0, pa1, pa2, pa3); SBAR();                                                           \
        if ((t) + 1 < NT) { SLOAD_H(Kh, Vh, KBASE((t) + 1)); SBAR(); }                                               \
        pv_tile<VB>(o, vb0, pa0, pa1, pa2, pa3); MASKT(PX0, PX1, (t)); partialSM(PX0, PX1, m_reg, mnX, alX);                                        \
        __syncthreads();                                                                                                      \
        if ((t) + 1 < NT) { VMW(); SWRITE_H(SB); }                                                                          \
        RESC(alX); __syncthreads(); } while (0)
    for (int t = 1; t + 1 < NT; t += 2) {
        HALF_STEP(pB0, pB1, mnB, alB, pA0, pA1, alA, t, 1, 0, 0);
        HALF_STEP(pA0, pA1, mnA, alA, pB0, pB1, alB, t + 1, 0, 1, 1);
    }
    const bool even = (NT & 1) == 0;
    if (even) { SBAR(); qkt<1>(pB0, pB1, K_lds, r32, hi, S.qr, q_lds); SBAR(); }
    finishSM(pA0, pA1, alA, l_reg, pa0, pa1, pa2, pa3); SBAR();
    SLOAD_H(nxt.K, nxt.V, kbn); SBAR();
#pragma unroll
    for (int d0 = 0; d0 < NQR; ++d0) S.qr[d0] = load8(nxt.Q + (size_t)(wid * QBLK + r32) * QS + d0 * 16 + hi * 8);
#pragma unroll
    for (int d0 = 0; d0 < NQL_; ++d0) S.qt[d0] = load8(nxt.Q + (size_t)(wid * QBLK + r32) * QS + (NQR + d0) * 16 + hi * 8);
    SBAR();
    pv_tile<0>(o, vb0, pa0, pa1, pa2, pa3);
    if (even) { MASKT(pB0, pB1, NT - 1); partialSM(pB0, pB1, m_reg, mnB, alB); __syncthreads(); RESC(alB);
        finishSM(pB0, pB1, alB, l_reg, pa0, pa1, pa2, pa3); SBAR(); pv_tile<1>(o, vb0, pa0, pa1, pa2, pa3); }
    SBAR(); SEAM_K0();
    if (hi == 0) li_l[r32] = l_reg; asm volatile("s_waitcnt lgkmcnt(0)" ::: "memory");
    float rli[16];
#pragma unroll
    for (int r = 0; r < 16; ++r) rli[r] = __builtin_amdgcn_rcpf(li_l[crow(r, hi)]);
    bf16* Ow = cur.O + (size_t)(wid * QBLK) * OS;
    {
        const bool odd = (r32 & 1) != 0; const int colp = r32 & ~1;
#pragma unroll
        for (int r = 0; r < 16; r += 2) { const int orow = crow(r, hi) + (odd ? 1 : 0);
#pragma unroll
            for (int d0 = 0; d0 < 4; ++d0) { const float va = o[d0][r] * rli[r], vb = o[d0][r + 1] * rli[r + 1];
                const float send = odd ? va : vb;
                const float recv = __builtin_bit_cast(float, __builtin_amdgcn_update_dpp(0, __builtin_bit_cast(int, send), 0xB1, 0xf, 0xf, false));
                const float lo = odd ? recv : va, hi2 = odd ? vb : recv;
                *(unsigned*)(Ow + (size_t)orow * OS + d0 * 32 + colp) = cvtpk(lo, hi2); } }
    }
    __syncthreads();
#undef RESC
#undef KBASE
#undef MASKT
#undef SEAM_K0
#undef HALF_STEP
}
#undef VROW
#undef KROW
#undef VMW
#undef VMWN
#undef SLOAD_H
#undef SWRITE_HK
#undef SWRITE_HV
#undef SWRITE_H
__device__ __forceinline__ BlockRef blk_ref(int bh, int qb, const bf16* Q, const bf16* K, const bf16* V, bf16* O) {
    const int b = bh / NH, h = bh % NH; const size_t rowb = (size_t)b * SEQ;
    BlockRef r;
    r.Q = Q + (rowb + (size_t)qb * QB) * QS + h * DK; r.O = O + (rowb + (size_t)qb * QB) * OS + h * DV;
    r.K = K + rowb * KS + h * DK; r.V = V + rowb * VS + h * 256 + 128; r.P0 = qb * QB;
    return r;
}
__device__ __forceinline__ void attn_phase(char* lds, const bf16* Q, const bf16* K, const bf16* V, bf16* O, int vcu, int G) {
    constexpr int NQB = SEQ / QB, NX = NQB / 2, TOTAL = 2 * NH * NX;
    int L = vcu; if (L >= TOTAL) return;
    int bh = L / NX, x = L % NX, pass = 0;
    BlockRef cur = blk_ref(bh, x, Q, K, V, O);
    Seam S;
    attn_prime(cur, SEQ, lds, S);
    for (;;) {
        const bool more_pass = pass == 0, more_item = L + G < TOTAL, last = !more_pass && !more_item;
        int bhn = bh, xn = x, passn = pass + 1, Ln = L;
        if (!more_pass) { passn = 0; Ln = more_item ? L + G : L; bhn = Ln / NX; xn = Ln % NX; }
        const BlockRef nxt = last ? cur : blk_ref(bhn, passn ? NQB - 1 - xn : xn, Q, K, V, O);
        attn_block(cur, nxt, SEQ, SEQ, lds, S);
        if (last) break;
        cur = nxt; bh = bhn; x = xn; pass = passn; L = Ln;
    }
}
#undef KSWZ
#undef SBAR
}
#define GAS __attribute__((address_space(1)))
#define LAS __attribute__((address_space(3)))
typedef unsigned short bf16;
typedef unsigned v4u __attribute__((ext_vector_type(4)));
typedef unsigned v2u __attribute__((ext_vector_type(2)));
typedef float f32x4 __attribute__((ext_vector_type(4)));
constexpr int NWAVES = 8;
constexpr int MTOK = 8192, DM = 2048, SEQL = 4096, CONVD = 1024, QL = 768, KVL = 512, INW = 8512, INWP = 8704, DFF = 5632, NHEAD = 16;
constexpr float EPS = 1e-6f;
constexpr size_t MiB = 1u << 20;
constexpr size_t WS_ZKR = 1, WS_WC = 2, WS_QB = 6, WS_KVB = 12, WS_MLA = 16, WS_WO = 24, WS_WIN = 32, WS_U1 = 66, WS_ZCONV = 98, WS_ZQ = 146, WS_ZKV = 158, WS_ZG = 166;
constexpr size_t WS_CM = 32, WS_QN = 48, WS_KVN = 60, WS_T1 = 68, WS_QRAW = 100, WS_KVRAW = 230, WS_KF = 294, WS_ATT = 32, WS_MIX = 100;
constexpr size_t WS_U2 = 36, WS_UP = 230, WS_DOWN = 176, WS_G = 68, WS_END = 347;
constexpr size_t WS_CST = 342, WS_SNT = 343, WS_KRR = 344, WS_KRSS = 346;
constexpr int LDS_BYTES = 147456;
constexpr int LDS_XCH = 131072;
constexpr int LDS_BARW = LDS_BYTES - 64;
constexpr size_t CTL_BYTES = 131072, WS_ROWSS = 65536;

#define LDS_WAIT() asm volatile("s_waitcnt lgkmcnt(0)" ::: "memory")
#define XB_TMO      128
#define XB_XCNT(j)  (256  + 64 * (j))
#define XB_XSUB(j)  (1280 + 64 * (j))
#define XB_XGEN(j)  (2304 + 64 * (j))
#define XB_TOP      3328
#define XB_TOPGEN   3392
#define XCD_BAR_WORDS 3456
#define XB_SPIN_CAP (1u << 18)

__device__ __forceinline__ unsigned xb_ld(unsigned* p)              { return __hip_atomic_load(p, __ATOMIC_RELAXED, __HIP_MEMORY_SCOPE_AGENT); }
__device__ __forceinline__ unsigned xb_add(unsigned* p, unsigned v) { return __hip_atomic_fetch_add(p, v, __ATOMIC_RELAXED, __HIP_MEMORY_SCOPE_AGENT); }
__device__ __forceinline__ unsigned xb_xcc_id() { return (unsigned)__builtin_amdgcn_s_getreg((3 << 11) | 20) & 0xFu; }
#define XB_SPIN(cond, bar) do { unsigned _sp = 0; while (cond) { __builtin_amdgcn_s_sleep(1); \
    if ((++_sp & 255u) == 0u) { if (xb_ld(&(bar)[XB_TMO])) break; if (_sp > XB_SPIN_CAP) { atomicAdd(&(bar)[XB_TMO], 1u); break; } } } } while (0)

struct XcdBarrier {
    unsigned* bar; unsigned x;
    volatile LAS unsigned* st;
};

__device__ __forceinline__ XcdBarrier xcd_barrier_post(unsigned* bar, volatile LAS unsigned* st) {
    XcdBarrier b; b.bar = bar; b.x = xb_xcc_id(); b.st = st;
    if (threadIdx.x == 0) (void)xb_add(&bar[XB_XCNT(b.x)], 1u);
    return b;
}
__device__ __forceinline__ void xcd_barrier_complete(unsigned* bar, unsigned x, unsigned& nloc, unsigned& nx) {
    const unsigned G = gridDim.x * gridDim.y * gridDim.z;
    unsigned sum, cnt, mine, sp = 0u;
    for (;;) {
        sum = 0u; cnt = 0u; mine = 0u;
#pragma unroll
        for (unsigned j = 0; j < 16; ++j) { const unsigned c = xb_ld(&bar[XB_XCNT(j)]); sum += c; cnt += (c > 0u) ? 1u : 0u; mine = (j == x) ? c : mine; }
        if (sum == G) break;
        __builtin_amdgcn_s_sleep(1);
        if ((++sp & 255u) == 0u) { if (xb_ld(&bar[XB_TMO])) break; if (sp > XB_SPIN_CAP) { atomicAdd(&bar[XB_TMO], 1u); break; } }
    }
    nloc = mine > 0u ? mine : 1u; nx = cnt > 0u ? cnt : 1u;
}

__device__ __forceinline__ void xcd_barrier(const XcdBarrier& b) {
    asm volatile("s_waitcnt vmcnt(0)" ::: "memory");
    __syncthreads();
    if (threadIdx.x == 0) {
        unsigned* bar = b.bar;
        __builtin_amdgcn_s_waitcnt(0);
        unsigned nloc = b.st[0], nx = b.st[1];
        if (nloc == 0u) { xcd_barrier_complete(bar, b.x, nloc, nx); b.st[0] = nloc; b.st[1] = nx; }
        const unsigned old = xb_add(&bar[XB_XSUB(b.x)], 1u);
        const unsigned gen = old / nloc;
        if (old + 1u == (gen + 1u) * nloc) {
            __builtin_amdgcn_fence(__ATOMIC_RELEASE, "agent");
            asm volatile("s_waitcnt vmcnt(0)" ::: "memory");
            const unsigned og = xb_add(&bar[XB_TOP], 1u);
            const unsigned tg = og / nx;
            if (og + 1u == (tg + 1u) * nx) xb_add(&bar[XB_TOPGEN], 1u);
            else XB_SPIN(xb_ld(&bar[XB_TOPGEN]) == tg, bar);
            __builtin_amdgcn_fence(__ATOMIC_ACQUIRE, "agent");
            asm volatile("s_waitcnt vmcnt(0)" ::: "memory");
        } else {
            XB_SPIN(xb_ld(&bar[XB_TOPGEN]) == gen, bar);
            __builtin_amdgcn_fence(__ATOMIC_ACQUIRE, "agent");
            asm volatile("s_waitcnt vmcnt(0)" ::: "memory");
        }
    }
    __syncthreads();
}

__device__ __forceinline__ unsigned xcd_barrier_arrive(const XcdBarrier& b) {
    asm volatile("s_waitcnt vmcnt(0)" ::: "memory");
    __syncthreads();
    unsigned gen = 0u;
    if (threadIdx.x == 0) {
        unsigned* bar = b.bar;
        __builtin_amdgcn_s_waitcnt(0);
        unsigned nloc = b.st[0], nx = b.st[1];
        if (nloc == 0u) { xcd_barrier_complete(bar, b.x, nloc, nx); b.st[0] = nloc; b.st[1] = nx; }
        const unsigned old = xb_add(&bar[XB_XSUB(b.x)], 1u);
        gen = old / nloc;
        if (old + 1u == (gen + 1u) * nloc) {
            __builtin_amdgcn_fence(__ATOMIC_RELEASE, "agent");
            asm volatile("s_waitcnt vmcnt(0)" ::: "memory");
            const unsigned og = xb_add(&bar[XB_TOP], 1u);
            const unsigned tg = og / nx;
            if (og + 1u == (tg + 1u) * nx) xb_add(&bar[XB_TOPGEN], 1u);
            asm volatile("s_waitcnt vmcnt(0)" ::: "memory");
        }
    }
    return gen;
}
__device__ __forceinline__ void xcd_barrier_wait(const XcdBarrier& b, unsigned gen) {
    asm volatile("s_waitcnt vmcnt(0)" ::: "memory");
    if (threadIdx.x == 0) {
        unsigned* bar = b.bar;
        XB_SPIN(xb_ld(&bar[XB_TOPGEN]) == gen, bar);
        __builtin_amdgcn_fence(__ATOMIC_ACQUIRE, "agent");
        asm volatile("s_waitcnt vmcnt(0)" ::: "memory");
    }
    __syncthreads();
}

__device__ __forceinline__ unsigned f2bf(float f) { unsigned u = __builtin_bit_cast(unsigned, f); return (u + 0x7fffu + ((u >> 16) & 1u)) >> 16; }
__device__ __forceinline__ unsigned pk2(float lo, float hi) { return pg8::cvt_pk_bf16(lo, hi); }
__device__ __forceinline__ float bf2f(bf16 h) { return __uint_as_float((unsigned)h << 16); }
__device__ __forceinline__ float wave_sum(float v) {
#pragma unroll
    for (int o = 1; o < 64; o <<= 1) v += __shfl_xor(v, o);
    return v;
}
__device__ __forceinline__ void unpack8(v4u w, float (&f)[8]) {
    f[0] = __uint_as_float(w.x << 16); f[1] = __uint_as_float(w.x & 0xffff0000u); f[2] = __uint_as_float(w.y << 16); f[3] = __uint_as_float(w.y & 0xffff0000u);
    f[4] = __uint_as_float(w.z << 16); f[5] = __uint_as_float(w.z & 0xffff0000u); f[6] = __uint_as_float(w.w << 16); f[7] = __uint_as_float(w.w & 0xffff0000u);
}
__device__ __forceinline__ v4u pack8f(const float (&f)[8]) { v4u o; o.x = pk2(f[0], f[1]); o.y = pk2(f[2], f[3]); o.z = pk2(f[4], f[5]); o.w = pk2(f[6], f[7]); return o; }
constexpr int TP = 65, TSCR_BYTES = 64 * TP * 4;
struct TJob { const float* W; bf16* WT; const float* kscale; int K, N, kb, nb, drow0, perm; };
__device__ __forceinline__ void tr_load(const TJob& j, f32x4 (&v)[16], int lane) {
    const int nq = lane & 15, kr = lane >> 4;
    const float* src = j.W + (size_t)(64 * j.kb + kr) * j.N + 64 * j.nb + 4 * nq;
#pragma unroll
    for (int i = 0; i < 16; ++i) v[i] = __builtin_nontemporal_load((const f32x4*)(src + (size_t)(4 * i) * j.N));
}
__device__ __forceinline__ void tr_store(const TJob& j, const f32x4 (&v)[16], LAS float* scr, int lane) {
    const int k0 = 64 * j.kb, nq = lane & 15, kr = lane >> 4;
#pragma unroll
    for (int i = 0; i < 16; ++i) { LAS float* d = scr + (4 * i + kr) * TP + 4 * nq; const float sc = j.kscale ? j.kscale[k0 + 4 * i + kr] : 1.f; d[0] = v[i].x * sc; d[1] = v[i].y * sc; d[2] = v[i].z * sc; d[3] = v[i].w * sc; }
    LDS_WAIT(); asm volatile("" ::: "memory");
    const int c = lane & 7;
#pragma unroll
    for (int jj = 0; jj < 8; ++jj) { const int n = (lane >> 3) + 8 * jj; const LAS float* q = scr + (8 * c) * TP + n; const int nd = j.perm ? 32 * ((n >> 4) & 1) + 8 * ((n >> 2) & 3) + 4 * (n >> 5) + (n & 3) : n;
        v4u o; o.x = pk2(q[0 * TP], q[1 * TP]); o.y = pk2(q[2 * TP], q[3 * TP]); o.z = pk2(q[4 * TP], q[5 * TP]); o.w = pk2(q[6 * TP], q[7 * TP]);
        *(v4u*)(j.WT + (size_t)(j.drow0 + nd) * j.K + k0 + 8 * c) = o; }
    LDS_WAIT(); asm volatile("" ::: "memory");
}
__device__ __forceinline__ void rms_row_2048(const float* xrow, const float* g, bf16* orow, int lane) {
    const f32x4* xr = (const f32x4*)xrow + lane; const f32x4* gr = (const f32x4*)g + lane;
    f32x4 v[8]; float s = 0.f;
#pragma unroll
    for (int j = 0; j < 8; ++j) { v[j] = __builtin_nontemporal_load(xr + 64 * j); s += (v[j].x * v[j].x + v[j].y * v[j].y) + (v[j].z * v[j].z + v[j].w * v[j].w); }
    const float r = rsqrtf(wave_sum(s) * (1.f / 2048.f) + EPS);
    v2u* o8 = (v2u*)orow + lane;
#pragma unroll
    for (int j = 0; j < 8; ++j) { const f32x4 gg = gr[64 * j]; v2u o; o.x = pk2(v[j].x * r * gg.x, v[j].y * r * gg.y); o.y = pk2(v[j].z * r * gg.z, v[j].w * r * gg.w); o8[64 * j] = o; }
}
__device__ const float INV_FREQ[32] = {1.000000000e+00f, 7.498942614e-01f, 5.623413324e-01f, 4.216965139e-01f, 3.162277639e-01f, 2.371373773e-01f, 1.778279394e-01f, 1.333521307e-01f,
    1.000000015e-01f, 7.498941571e-02f, 5.623413250e-02f, 4.216965288e-02f, 3.162277490e-02f, 2.371373773e-02f, 1.778279431e-02f, 1.333521493e-02f,
    9.999999776e-03f, 7.498941850e-03f, 5.623413250e-03f, 4.216964822e-03f, 3.162277630e-03f, 2.371373586e-03f, 1.778279431e-03f, 1.333521446e-03f,
    1.000000047e-03f, 7.498942432e-04f, 5.623413017e-04f, 4.216965172e-04f, 3.162277571e-04f, 2.371373703e-04f, 1.778279402e-04f, 1.333521504e-04f};


constexpr int I_IN = (DM / 64) * (INW / 64), I_WC = (CONVD / 64) * (DM / 64), I_QB = (QL / 64) * (3072 / 64), I_KVB = (KVL / 64) * (4096 / 64), I_SQ = (DM / 64) * (DM / 64);
constexpr int I_UP = (DM / 64) * (2 * DFF / 64), I_DN = (DFF / 64) * (DM / 64);
__device__ __forceinline__ TJob job0(int it, const float* w_in, const float* w_co, const float* w_qb, const float* w_kvb, const float* w_mla, const float* w_o,
                                     bf16* win_t, bf16* wc_t, bf16* qb_t, bf16* kvb_t, bf16* mla_t, bf16* wo_t) {
    int r = it; TJob j; j.kscale = nullptr; j.perm = 0;
    if (r < I_IN) { const int nblk = INW / 64; j.kb = r / nblk; j.nb = r % nblk; const int n0 = 64 * j.nb;
        j.drow0 = n0 < 4352 ? n0 : (n0 < 4416 ? 8448 + (n0 - 4352) : 4352 + (n0 - 4416)); j.W = w_in; j.K = DM; j.N = INW; j.WT = win_t; return j; } r -= I_IN;
    if (r < I_WC) { const int nblk = DM / 64; j.kb = r / nblk; j.nb = r % nblk; j.drow0 = 64 * j.nb; j.W = w_co; j.K = CONVD; j.N = DM; j.WT = wc_t; return j; } r -= I_WC;
    if (r < I_QB) { const int nblk = 3072 / 64; j.kb = r / nblk; j.nb = r % nblk; const int hh = j.nb / 3, part = j.nb % 3; j.drow0 = 256 * hh + 64 * part; j.perm = part == 2 ? 1 : 0;
        j.W = w_qb; j.K = QL; j.N = 3072; j.WT = qb_t; return j; } r -= I_QB;
    if (r < I_KVB) { const int nblk = 4096 / 64; j.kb = r / nblk; j.nb = r % nblk; j.drow0 = 64 * j.nb; j.W = w_kvb; j.K = KVL; j.N = 4096; j.WT = kvb_t; return j; } r -= I_KVB;
    const int nblk = DM / 64; const bool second = r >= I_SQ; if (second) r -= I_SQ;
    j.kb = r / nblk; j.nb = r % nblk; j.drow0 = 64 * j.nb; j.W = second ? w_o : w_mla; j.K = DM; j.N = DM; j.WT = second ? wo_t : mla_t; return j;
}
__device__ __forceinline__ TJob job8(int it, const float* w_up, const float* w_dn, const float* ln2g, bf16* up_t, bf16* down_t) {
    int r = it; TJob j; j.perm = 0;
    if (r < I_UP) { const int nblk = 2 * DFF / 64; j.kb = r / nblk; j.nb = r % nblk; const int n0 = 64 * j.nb, hf = n0 >= DFF ? 1 : 0, jc = n0 - hf * DFF;
        j.drow0 = 256 * (jc / 128) + 128 * hf + (jc % 128); j.W = w_up; j.K = DM; j.N = 2 * DFF; j.WT = up_t; j.kscale = ln2g; return j; } r -= I_UP;
    const int nblk = DM / 64; j.kb = r / nblk; j.nb = r % nblk; j.drow0 = 64 * j.nb; j.W = w_dn; j.K = DFF; j.N = DM; j.WT = down_t; j.kscale = nullptr; return j;
}
struct Args { const float* in[20]; float* out; unsigned char* ws; };

__global__ void __launch_bounds__(NWAVES * 64, 2) fwd_kernel(Args a) {
    extern __shared__ __attribute__((aligned(16))) unsigned char lds[];
    cg::grid_group grid = cg::this_grid();
    const int G = gridDim.x, bx = blockIdx.x, vcu = (G % 8 == 0) ? (bx % 8) * (G / 8) + bx / 8 : bx;
    const int NGW = G * NWAVES;
    LAS unsigned char* ldsl = (LAS unsigned char*)lds;
    if (threadIdx.x < 16) ((LAS unsigned*)(ldsl + LDS_BARW))[threadIdx.x] = 0u;
    __syncthreads();
    const XcdBarrier bar = xcd_barrier_post((unsigned*)a.ws, (volatile LAS unsigned*)(ldsl + LDS_BARW));
#define PHASE_IDS() int tid_ = threadIdx.x; asm volatile("" : "+v"(tid_)); const int tid = tid_, lane = tid & 63, wave = __builtin_amdgcn_readfirstlane(tid >> 6), gw = vcu * NWAVES + wave; \
    LAS float* scr = (LAS float*)(ldsl + wave * TSCR_BYTES); (void)scr; (void)gw; (void)lane; (void)tid
    unsigned char* ws = a.ws;
    const float* x = a.in[0]; const int* positions = (const int*)a.in[1];
    bf16* zkr = (bf16*)(ws + WS_ZKR * MiB); bf16* wc_t = (bf16*)(ws + WS_WC * MiB); bf16* qb_t = (bf16*)(ws + WS_QB * MiB); bf16* kvb_t = (bf16*)(ws + WS_KVB * MiB);
    bf16* mla_t = (bf16*)(ws + WS_MLA * MiB); bf16* wo_t = (bf16*)(ws + WS_WO * MiB); bf16* win_t = (bf16*)(ws + WS_WIN * MiB); bf16* u1 = (bf16*)(ws + WS_U1 * MiB);
    bf16* zconv = (bf16*)(ws + WS_ZCONV * MiB); bf16* zq = (bf16*)(ws + WS_ZQ * MiB); bf16* zkv = (bf16*)(ws + WS_ZKV * MiB); bf16* zg = (bf16*)(ws + WS_ZG * MiB);
    bf16* cm = (bf16*)(ws + WS_CM * MiB); bf16* qn = (bf16*)(ws + WS_QN * MiB); bf16* kvn = (bf16*)(ws + WS_KVN * MiB); bf16* t1 = (bf16*)(ws + WS_T1 * MiB);
    bf16* qraw = (bf16*)(ws + WS_QRAW * MiB); bf16* kvraw = (bf16*)(ws + WS_KVRAW * MiB); bf16* kf = (bf16*)(ws + WS_KF * MiB); bf16* attb = (bf16*)(ws + WS_ATT * MiB);
    bf16* mixb = (bf16*)(ws + WS_MIX * MiB); float* rowss = (float*)(ws + WS_ROWSS);
    float* cst = (float*)(ws + WS_CST * MiB); float* snt = (float*)(ws + WS_SNT * MiB); float* krr = (float*)(ws + WS_KRR * MiB); float* krss = (float*)(ws + WS_KRSS * MiB);
    bf16* down_t = (bf16*)(ws + WS_DOWN * MiB); bf16* gbuf = (bf16*)(ws + WS_G * MiB); bf16* u2 = (bf16*)(ws + WS_U2 * MiB); bf16* up_t = (bf16*)(ws + WS_UP * MiB);

    {
        PHASE_IDS();
        {
            f32x4 va[16], vb[16]; int it = gw;
            if (it < I_IN) { TJob ja = job0(it, a.in[3], a.in[6], a.in[8], a.in[10], a.in[13], a.in[14], win_t, wc_t, qb_t, kvb_t, mla_t, wo_t); tr_load(ja, va, lane);
                for (;;) {
                    const int itb = it + NGW; TJob jb; const bool hb = itb < I_IN; if (hb) { jb = job0(itb, a.in[3], a.in[6], a.in[8], a.in[10], a.in[13], a.in[14], win_t, wc_t, qb_t, kvb_t, mla_t, wo_t); tr_load(jb, vb, lane); }
                    tr_store(ja, va, scr, lane); if (!hb) break;
                    const int itc = itb + NGW; const bool hc = itc < I_IN; if (hc) { ja = job0(itc, a.in[3], a.in[6], a.in[8], a.in[10], a.in[13], a.in[14], win_t, wc_t, qb_t, kvb_t, mla_t, wo_t); tr_load(ja, va, lane); }
                    tr_store(jb, vb, scr, lane); if (!hc) break;
                    it = itc;
                } }
        }
        { v4u* p = (v4u*)(win_t + (size_t)INW * DM); const int n16 = (INWP - INW) * DM * 2 / 16; const v4u z = {0u, 0u, 0u, 0u};
          for (int i = (vcu * NWAVES * 64) + tid; i < n16; i += G * NWAVES * 64) p[i] = z;
          constexpr int PR16 = 64 * QL * 2 / 16;
          for (int i = (vcu * NWAVES * 64) + tid; i < NHEAD * PR16; i += G * NWAVES * 64) ((v4u*)(qb_t + (size_t)(256 * (i / PR16) + 192) * QL))[i % PR16] = z; }
        for (int m = gw; m < MTOK; m += NGW) rms_row_2048(x + (size_t)m * DM, a.in[2], u1 + (size_t)m * DM, lane);
    }
    xcd_barrier(bar);
    if (__builtin_expect(gridDim.y > 1u, 0)) grid.sync();
    {
        pg8::Gemm g{u1, win_t, MTOK, INWP, DM}; pg8::StaticOrder S; S.init(MTOK, INWP, G, bx);
        pg8::EpiIn E{zconv, zq, zkv, zg, zkr, a.in[4]};
        pg8::gemm_phase<pg8::EpiIn, pg8::StaticOrder, true, true>(ldsl, g, S, E);
        {
            PHASE_IDS();
            constexpr int NUNITS = (MTOK / 256) * (INWP / 256), NDEF = I_IN + I_WC + I_QB + I_KVB + 2 * I_SQ;
            const int iL = (NUNITS - 1) / G, nlast = NUNITS - iL * G, idle = G - nlast;
            const int npart = idle > 0 ? idle : G, rank = idle > 0 ? bx - nlast : bx;
            if (rank >= 0) {
        {
                f32x4 va[16], vb[16]; int it = I_IN + rank * NWAVES + wave;
                if (it < NDEF) { TJob ja = job0(it, a.in[3], a.in[6], a.in[8], a.in[10], a.in[13], a.in[14], win_t, wc_t, qb_t, kvb_t, mla_t, wo_t); tr_load(ja, va, lane);
                    for (;;) {
                        const int itb = it + npart * NWAVES; TJob jb; const bool hb = itb < NDEF; if (hb) { jb = job0(itb, a.in[3], a.in[6], a.in[8], a.in[10], a.in[13], a.in[14], win_t, wc_t, qb_t, kvb_t, mla_t, wo_t); tr_load(jb, vb, lane); }
                        tr_store(ja, va, scr, lane); if (!hb) break;
                        const int itc = itb + npart * NWAVES; const bool hc = itc < NDEF; if (hc) { ja = job0(itc, a.in[3], a.in[6], a.in[8], a.in[10], a.in[13], a.in[14], win_t, wc_t, qb_t, kvb_t, mla_t, wo_t); tr_load(ja, va, lane); }
                        tr_store(jb, vb, scr, lane); if (!hc) break;
                        it = itc;
                    } }
            }
            }
        }
    }
    xcd_barrier(bar);
    {
        PHASE_IDS();
        const float* cw = a.in[5]; const float* qg = a.in[7]; const float* kvg = a.in[9];
        const float gkr = a.in[12][128 + lane], ifq = INV_FREQ[lane & 31];
        for (int m = gw; m < MTOK; m += NGW) {
            const int t = m & (SEQL - 1);
            const bf16* zr = zconv + (size_t)m * 3072;
#pragma unroll
            for (int ch = 0; ch < 2; ++ch) {
                const int c = ch * 512 + lane * 8;
                const v4u z4 = {0u, 0u, 0u, 0u};
                const v4u zb = *(const v4u*)(zr + c), zc0 = *(const v4u*)(zr + 1024 + c), zv0 = *(const v4u*)(zr + 2048 + c);
                const v4u zc1 = t >= 1 ? *(const v4u*)(zr - 3072 + 1024 + c) : z4, zv1 = t >= 1 ? *(const v4u*)(zr - 3072 + 2048 + c) : z4;
                const v4u zc2 = t >= 2 ? *(const v4u*)(zr - 6144 + 1024 + c) : z4, zv2 = t >= 2 ? *(const v4u*)(zr - 6144 + 2048 + c) : z4;
                float fb[8], fc0[8], fv0[8], fc1[8], fv1[8], fc2[8], fv2[8], w0[8], w1[8], w2[8], o[8];
                unpack8(zb, fb); unpack8(zc0, fc0); unpack8(zv0, fv0); unpack8(zc1, fc1); unpack8(zv1, fv1); unpack8(zc2, fc2); unpack8(zv2, fv2);
                *(f32x4*)&w0[0] = *(const f32x4*)(cw + c); *(f32x4*)&w0[4] = *(const f32x4*)(cw + c + 4);
                *(f32x4*)&w1[0] = *(const f32x4*)(cw + 1024 + c); *(f32x4*)&w1[4] = *(const f32x4*)(cw + 1024 + c + 4);
                *(f32x4*)&w2[0] = *(const f32x4*)(cw + 2048 + c); *(f32x4*)&w2[4] = *(const f32x4*)(cw + 2048 + c + 4);
#pragma unroll
                for (int e = 0; e < 8; ++e) o[e] = fb[e] * (w0[e] * (fc2[e] * fv2[e]) + w1[e] * (fc1[e] * fv1[e]) + w2[e] * (fc0[e] * fv0[e]));
                *(v4u*)(cm + (size_t)m * CONVD + c) = pack8f(o);
            }
            {
                const bf16* qr = zq + (size_t)m * QL;
                const v4u qa = *(const v4u*)(qr + lane * 8); const v2u qb2 = *(const v2u*)(qr + 512 + lane * 4);
                float fa[8]; unpack8(qa, fa);
                float fb4[4] = {__uint_as_float(qb2.x << 16), __uint_as_float(qb2.x & 0xffff0000u), __uint_as_float(qb2.y << 16), __uint_as_float(qb2.y & 0xffff0000u)};
                float s = 0.f;
#pragma unroll
                for (int e = 0; e < 8; ++e) s += fa[e] * fa[e];
#pragma unroll
                for (int e = 0; e < 4; ++e) s += fb4[e] * fb4[e];
                const float r = rsqrtf(wave_sum(s) * (1.f / 768.f) + EPS);
                const f32x4 g0 = *(const f32x4*)(qg + lane * 8), g1 = *(const f32x4*)(qg + lane * 8 + 4), g2 = *(const f32x4*)(qg + 512 + lane * 4);
                float oa[8] = {fa[0] * r * g0.x, fa[1] * r * g0.y, fa[2] * r * g0.z, fa[3] * r * g0.w, fa[4] * r * g1.x, fa[5] * r * g1.y, fa[6] * r * g1.z, fa[7] * r * g1.w};
                *(v4u*)(qn + (size_t)m * QL + lane * 8) = pack8f(oa);
                v2u ob; ob.x = pk2(fb4[0] * r * g2.x, fb4[1] * r * g2.y); ob.y = pk2(fb4[2] * r * g2.z, fb4[3] * r * g2.w);
                *(v2u*)(qn + (size_t)m * QL + 512 + lane * 4) = ob;
            }
            {
                const float ang = (float)positions[m] * ifq; const double rev = (double)ang * 0.15915494309189535; const float frc = (float)(rev - __builtin_floor(rev));
                const float cs = __builtin_amdgcn_cosf(frc), sn = __builtin_amdgcn_sinf(frc);
                if (lane < 32) { cst[(size_t)m * 32 + lane] = cs; snt[(size_t)m * 32 + lane] = sn; }
                const float kr = bf2f(zkr[(size_t)m * 64 + lane]); const float kss = wave_sum(kr * kr); if (lane == 0) krss[m] = kss;
                const float v = kr * gkr, pt = __shfl_xor(v, 32);
                krr[(size_t)m * 64 + lane] = lane < 32 ? v * cs - pt * sn : v * cs + pt * sn;
            }
            {
                const v4u ka = *(const v4u*)(zkv + (size_t)m * KVL + lane * 8);
                float fa[8]; unpack8(ka, fa); float s = 0.f;
#pragma unroll
                for (int e = 0; e < 8; ++e) s += fa[e] * fa[e];
                const float r = rsqrtf(wave_sum(s) * (1.f / 512.f) + EPS);
                const f32x4 g0 = *(const f32x4*)(kvg + lane * 8), g1 = *(const f32x4*)(kvg + lane * 8 + 4);
                float oa[8] = {fa[0] * r * g0.x, fa[1] * r * g0.y, fa[2] * r * g0.z, fa[3] * r * g0.w, fa[4] * r * g1.x, fa[5] * r * g1.y, fa[6] * r * g1.z, fa[7] * r * g1.w};
                *(v4u*)(kvn + (size_t)m * KVL + lane * 8) = pack8f(oa);
            }
        }
    }
    xcd_barrier(bar);
    {
        { pg8::Gemm g{cm, wc_t, MTOK, DM, CONVD}; pg8::StaticOrder S; S.init(MTOK, DM, G, bx);
          pg8::EpiFma E{t1, DM, zg, 4096, 0, nullptr, 0};
          pg8::gemm_phase<pg8::EpiFma, pg8::StaticOrder, true, true>(ldsl, g, S, E); }
        { pg8::Gemm g{qn, qb_t, MTOK, 4096, QL}; pg8::StaticOrder S; S.init(MTOK, 4096, G, bx);
          pg8::EpiQ E{qraw, a.in[11], cst, snt, (LAS float*)(ldsl + LDS_XCH)};
          pg8::gemm_phase<pg8::EpiQ, pg8::StaticOrder, true, true>(ldsl, g, S, E); }
        { pg8::Gemm g{kvn, kvb_t, MTOK, 4096, KVL}; pg8::StaticOrder S; S.init(MTOK, 4096, G, bx);
          pg8::EpiKV E{kf, kvraw, a.in[12], krr, krss, (LAS float*)(ldsl + LDS_XCH)};
          pg8::gemm_phase<pg8::EpiKV, pg8::StaticOrder, true, true>(ldsl, g, S, E); }
    }
    xcd_barrier(bar);
    att::attn_phase((char*)lds, (const att::bf16*)qraw, (const att::bf16*)kf, (const att::bf16*)kvraw, (att::bf16*)attb, vcu, G);
    xcd_barrier(bar);
    {
        pg8::Gemm g{attb, mla_t, MTOK, DM, DM}; pg8::StaticOrder S; S.init(MTOK, DM, G, bx);
        pg8::EpiFma E{mixb, DM, zg, 4096, 2048, t1, DM};
        pg8::gemm_phase<pg8::EpiFma, pg8::StaticOrder, true, true>(ldsl, g, S, E);
    }
    const unsigned seam67 = xcd_barrier_arrive(bar);
    {
        PHASE_IDS();
        {
            constexpr int NITEMS = I_UP;     f32x4 va[16], vb[16]; int it = gw;
            if (it < NITEMS) { TJob ja = job8(it, a.in[16], a.in[19], a.in[15], up_t, down_t); tr_load(ja, va, lane);
                for (;;) {
                    const int itb = it + NGW; TJob jb; const bool hb = itb < NITEMS; if (hb) { jb = job8(itb, a.in[16], a.in[19], a.in[15], up_t, down_t); tr_load(jb, vb, lane); }
                    tr_store(ja, va, scr, lane); if (!hb) break;
                    const int itc = itb + NGW; const bool hc = itc < NITEMS; if (hc) { ja = job8(itc, a.in[16], a.in[19], a.in[15], up_t, down_t); tr_load(ja, va, lane); }
                    tr_store(jb, vb, scr, lane); if (!hc) break;
                    it = itc;
                } }
        }
    }
    xcd_barrier_wait(bar, seam67);
    {
        pg8::Gemm g{mixb, wo_t, MTOK, DM, DM}; pg8::StaticOrder S; S.init(MTOK, DM, G, bx);
        pg8::EpiResNorm E{x, a.out, u2, rowss, DM};
        pg8::gemm_phase<pg8::EpiResNorm, pg8::StaticOrder, true, true>(ldsl, g, S, E);
    }
    xcd_barrier(bar);
    {
        pg8::Gemm g{u2, up_t, MTOK, 2 * DFF, DM}; pg8::UpOrder S; S.init(G, bx);
        pg8::EpiUpGate E{gbuf, a.in[17], a.in[18], (LAS float*)(ldsl + LDS_XCH), rowss};
        pg8::gemm_phase<pg8::EpiUpGate, pg8::UpOrder, true, true>(ldsl, g, S, E);
        {
            PHASE_IDS();
            constexpr int NUNITS = 34 * 44;
            const int iL = (NUNITS - 1) / G, nlast = NUNITS - iL * G, idle = G - nlast;
            const int npart = idle > 0 ? idle : G, rank = idle > 0 ? bx - nlast : bx;
            if (rank >= 0)
            {
                constexpr int NITEMS = I_UP + I_DN; f32x4 va[16], vb[16]; int it = I_UP + rank * NWAVES + wave;
                if (it < NITEMS) { TJob ja = job8(it, a.in[16], a.in[19], a.in[15], up_t, down_t); tr_load(ja, va, lane);
                    for (;;) {
                        const int itb = it + npart * NWAVES; TJob jb; const bool hb = itb < NITEMS; if (hb) { jb = job8(itb, a.in[16], a.in[19], a.in[15], up_t, down_t); tr_load(jb, vb, lane); }
                        tr_store(ja, va, scr, lane); if (!hb) break;
                        const int itc = itb + npart * NWAVES; const bool hc = itc < NITEMS; if (hc) { ja = job8(itc, a.in[16], a.in[19], a.in[15], up_t, down_t); tr_load(ja, va, lane); }
                        tr_store(jb, vb, scr, lane); if (!hc) break;
                        it = itc;
                    } }
            }
        }
    }
    xcd_barrier(bar);
    {
        pg8::Gemm g{gbuf, down_t, MTOK, DM, DFF}; pg8::StaticOrder S; S.init(MTOK, DM, G, bx);
        pg8::EpiResF32 E{a.out, a.out, DM, true};
        pg8::gemm_phase<pg8::EpiResF32, pg8::StaticOrder, true, true>(ldsl, g, S, E);
    }
}

extern "C" void kernel_launch(void* const* d_in, const int* in_sizes, int n_in, void* d_out, int out_size, void* d_ws, size_t ws_size, hipStream_t stream) {
    static int grid = 0;
    if (grid == 0) {
        if (n_in != 20 || out_size != MTOK * DM || ws_size < WS_END * MiB) { fprintf(stderr, "kernel_launch: unexpected shapes (n_in %d, out %d, ws %zu)\n", n_in, out_size, ws_size); grid = -1; return; }
        int dev = 0, cus = 0, per_cu = 0;
        (void)hipGetDevice(&dev); (void)hipDeviceGetAttribute(&cus, hipDeviceAttributeMultiprocessorCount, dev);
        if (hipFuncSetAttribute((const void*)fwd_kernel, hipFuncAttributeMaxDynamicSharedMemorySize, LDS_BYTES) != hipSuccess) { fprintf(stderr, "kernel_launch: hipFuncSetAttribute failed\n"); grid = -1; return; }
        if (hipOccupancyMaxActiveBlocksPerMultiprocessor(&per_cu, (const void*)fwd_kernel, NWAVES * 64, LDS_BYTES) != hipSuccess || per_cu < 1) { fprintf(stderr, "kernel_launch: occupancy query says %d blocks per CU\n", per_cu); grid = -1; return; }
        grid = cus;
    }
    if (grid < 0) return;
    if (hipMemsetAsync(d_ws, 0, CTL_BYTES, stream) != hipSuccess) { fprintf(stderr, "kernel_launch: memset of the barrier words failed\n"); return; }
    Args a{};
    for (int i = 0; i < 20; ++i) a.in[i] = (const float*)d_in[i];
    a.out = (float*)d_out; a.ws = (unsigned char*)d_ws;
    void* args[] = {&a};
    hipError_t e = hipLaunchCooperativeKernel((const void*)fwd_kernel, dim3(grid), dim3(NWAVES * 64), args, LDS_BYTES, stream);
    if (e != hipSuccess) fprintf(stderr, "kernel_launch: cooperative launch failed: %s (grid %d)\n", hipGetErrorString(e), grid);
}
```

```cpp
#include <hip/hip_runtime.h>
#include <hip/hip_cooperative_groups.h>
#include <hip/hip_bf16.h>
#include <cstdio>
#include <cstdint>
namespace cg = cooperative_groups;
namespace pg8 {
#define PG8_LAS __attribute__((address_space(3)))
typedef unsigned short bf16_t;
typedef short bf16x8 __attribute__((ext_vector_type(8)));
typedef float f32x4 __attribute__((ext_vector_type(4)));
typedef unsigned u32x4 __attribute__((ext_vector_type(4)));
constexpr int BM = 256, BK = 64, HALF = 128, HTB = HALF * BK * 2  , STAGE_BYTES = 8 * HTB, NXCD = 8, WGM = 4;

__host__ __device__ __forceinline__ int lds_byte(int r, int c) { const int st = (r >> 4) * 2 + (c >> 5), rr = r & 15, cc = c & 31, ob = rr * 64 + cc * 2; return st * 1024 + (ob ^ (((ob >> 9) & 1) << 5)); }
__host__ __device__ __forceinline__ void stage_rc(int b, int& R, int& C) { const int st = b / 1024, sb = b % 1024, swz = sb ^ (((sb >> 9) & 1) << 5); R = (st >> 1) * 16 + swz / 64; C = (st & 1) * 32 + (swz % 64) / 2; }
__host__ __device__ __forceinline__ int perm32(int rho) { const int n = rho >> 4, i = rho & 15; return 8 * (i >> 2) + 4 * n + (i & 3); }

struct Unit { int pm, pn; };
struct Gemm { const bf16_t* A; const bf16_t* Bt; int M, N, K; };

struct StaticOrder {
    int nM, nN, nwg, G, c;
    __host__ __device__ void init(int M, int N, int G_, int c_) { nM = M / BM; nN = N / BM; nwg = nM * nN; G = G_; c = c_; }
    __host__ __device__ bool next(int i, Unit& u) const {
        const long L = (long)i * G + c; if (L >= nwg) return false;
        int wgid = (int)L; { const int q = nwg / NXCD, r = nwg % NXCD, xcd = wgid % NXCD, off = wgid / NXCD; wgid = (xcd < r ? xcd * (q + 1) : r * (q + 1) + (xcd - r) * q) + off; }
        const int nig = WGM * nN, gid = wgid / nig, fm = gid * WGM, gsz = (nM - fm) < WGM ? (nM - fm) : WGM;
        u.pm = fm + ((wgid % nig) % gsz); u.pn = (wgid % nig) / gsz; return true;
    }
    __device__ __forceinline__ int a_row(const Unit& u) const { return u.pm * BM; }
    __device__ __forceinline__ void a_ready(const Unit&) const {}
    __device__ __forceinline__ void done(const Unit&) const {}
};
struct UpOrder {
    int nM, nN, nwg, G, c;
    __host__ __device__ void init(int G_, int c_) { nM = 34; nN = 44; nwg = nM * nN; G = G_; c = c_; }
    __host__ __device__ bool next(int i, Unit& u) const {
        const long L = (long)i * G + c; if (L >= nwg) return false;
        int wgid = (int)L; { const int q = nwg / NXCD, r = nwg % NXCD, xcd = wgid % NXCD, off = wgid / NXCD; wgid = (xcd < r ? xcd * (q + 1) : r * (q + 1) + (xcd - r) * q) + off; }
        const int nig = WGM * nN, gid = wgid / nig, fm = gid * WGM, gsz = (nM - fm) < WGM ? (nM - fm) : WGM;
        u.pm = fm + ((wgid % nig) % gsz); u.pn = (wgid % nig) / gsz; return true;
    }
    __device__ __forceinline__ int a_row(const Unit& u) const { return (u.pm / 17) * 4096 + 254 * (u.pm % 17) - 2; }
    __device__ __forceinline__ void a_ready(const Unit&) const {}
    __device__ __forceinline__ void done(const Unit&) const {}
};

__device__ __forceinline__ unsigned cvt_pk_bf16(float lo, float hi) { unsigned r; asm volatile("v_cvt_pk_bf16_f32 %0, %1, %2" : "=v"(r) : "v"(lo), "v"(hi)); return r; }
typedef float f32x2 __attribute__((ext_vector_type(2)));
__device__ __forceinline__ f32x2 gelu_pk(f32x2 v) {
    const f32x2 av = __builtin_elementwise_abs(v), d = av * 0.2316418882f + 1.0f;
    f32x2 t; t.x = __builtin_amdgcn_rcpf(d.x); t.y = __builtin_amdgcn_rcpf(d.y);
    f32x2 q = t * 0.5307027145f + (-0.7265760135f); q = q * t + 0.7107068705f; q = q * t + (-0.142248368f); q = q * t + 0.127414796f; q = q * t;
    const f32x2 s = (v * v) * (-0.72134752044f);
    f32x2 e; e.x = __builtin_amdgcn_exp2f(s.x); e.y = __builtin_amdgcn_exp2f(s.y);
    const f32x2 m = v * (q * e), r = v - m;
    f32x2 o; o.x = v.x < 0.f ? m.x : r.x; o.y = v.y < 0.f ? m.y : r.y; return o;
}

template <int ACT  > struct EpiBf16 {
    static constexpr bool PERM = true, AFTER_DRAIN = false; static_assert(ACT == 0 || ACT == 1, "EpiBf16: ACT is 0 (none) or 1 (gelu_pk)");
    bf16_t* O; int ldc; const float* bias; int split_cols; size_t split_stride; float scale0;
    __device__ __forceinline__ void operator()(const f32x4 (&acc)[2][2][4][2], const Unit& u, int wr, int wc, int fr, int fq) const {
        const int row0 = u.pm * BM + wr * 64 + fr; int colt = u.pn * BM; bf16_t* base = O;
        float sc = 1.f; if (split_cols) { const int t = colt / split_cols; base += (size_t)t * split_stride; colt -= t * split_cols; if (t == 0) sc = scale0; }
        const int col0 = colt + wc * 32 + 8 * fq, bcol0 = u.pn * BM + wc * 32 + 8 * fq;
        f32x4 bv[2][2];
#pragma unroll
        for (int bj = 0; bj < 2; ++bj)
#pragma unroll
            for (int n = 0; n < 2; ++n) bv[bj][n] = bias ? *(const f32x4*)(bias + bcol0 + bj * HALF + 4 * n) : (f32x4){0.f, 0.f, 0.f, 0.f};
#pragma unroll
        for (int ai = 0; ai < 2; ++ai)
#pragma unroll
            for (int m = 0; m < 4; ++m) { bf16_t* rowp = base + (size_t)(row0 + ai * HALF + m * 16) * ldc + col0;
#pragma unroll
                for (int bj = 0; bj < 2; ++bj) { f32x4 v0 = acc[ai][bj][m][0] + bv[bj][0], v1 = acc[ai][bj][m][1] + bv[bj][1];
                    if (ACT == 1) { f32x2 a = gelu_pk((f32x2){v0[0], v0[1]}), b = gelu_pk((f32x2){v0[2], v0[3]}), c = gelu_pk((f32x2){v1[0], v1[1]}), d = gelu_pk((f32x2){v1[2], v1[3]});
                        v0 = (f32x4){a.x, a.y, b.x, b.y}; v1 = (f32x4){c.x, c.y, d.x, d.y}; }
                    v0 = v0 * sc; v1 = v1 * sc; u32x4 w; w.x = cvt_pk_bf16(v0[0], v0[1]); w.y = cvt_pk_bf16(v0[2], v0[3]); w.z = cvt_pk_bf16(v1[0], v1[1]); w.w = cvt_pk_bf16(v1[2], v1[3]);
                    *(u32x4*)(rowp + bj * HALF) = w; } }
    }
};
__device__ __forceinline__ float sigmoid_f(float x) { return __builtin_amdgcn_rcpf(1.0f + __builtin_amdgcn_exp2f(-1.4426950408889634f * x)); }
__device__ __forceinline__ float bf_lo(unsigned w) { return __uint_as_float(w << 16); }
__device__ __forceinline__ float bf_hi(unsigned w) { return __uint_as_float(w & 0xffff0000u); }
__device__ __forceinline__ float sum_rows4(float s) {
    { auto r = __builtin_amdgcn_permlane16_swap(__float_as_uint(s), __float_as_uint(s), false, false); s = __uint_as_float(r[0]) + __uint_as_float(r[1]); }
    { auto r = __builtin_amdgcn_permlane32_swap(__float_as_uint(s), __float_as_uint(s), false, false); s = __uint_as_float(r[0]) + __uint_as_float(r[1]); }
    return s;
}
struct EpiIn {
    static constexpr bool PERM = true, AFTER_DRAIN = false;
    bf16_t *zconv, *zq, *zkv, *zg, *zkr; const float* bgate;
    __device__ __forceinline__ void operator()(const f32x4 (&acc)[2][2][4][2], const Unit& u, int wr, int wc, int fr, int fq) const {
        const int pn = u.pn; bf16_t* dst; int ldc, ct, mode = 0;
        if (pn < 12) { dst = zconv; ldc = 3072; ct = pn * 256; }
        else if (pn < 15) { dst = zq; ldc = 768; ct = (pn - 12) * 256; }
        else if (pn < 17) { dst = zkv; ldc = 512; ct = (pn - 15) * 256; }
        else if (pn < 33) { dst = zg; ldc = 4096; ct = (pn - 17) * 256; mode = 1; }
        else { dst = zkr; ldc = 64; ct = 0; mode = 2; }
        const int row0 = u.pm * BM + wr * 64 + fr, c0 = wc * 32 + 8 * fq;
#pragma unroll
        for (int bj = 0; bj < 2; ++bj) {
            const int c = c0 + bj * HALF;
            if (mode == 2 && c >= 64) continue;
            f32x4 b0 = (f32x4){0.f, 0.f, 0.f, 0.f}, b1 = b0;
            if (mode == 1) { b0 = *(const f32x4*)(bgate + ct + c); b1 = *(const f32x4*)(bgate + ct + c + 4); }
#pragma unroll
            for (int ai = 0; ai < 2; ++ai)
#pragma unroll
                for (int m = 0; m < 4; ++m) {
                    f32x4 v0 = acc[ai][bj][m][0] + b0, v1 = acc[ai][bj][m][1] + b1;
                    if (mode == 1) {
#pragma unroll
                        for (int e = 0; e < 4; ++e) { v0[e] = sigmoid_f(v0[e]); v1[e] = sigmoid_f(v1[e]); }
                    }
                    u32x4 w; w.x = cvt_pk_bf16(v0[0], v0[1]); w.y = cvt_pk_bf16(v0[2], v0[3]); w.z = cvt_pk_bf16(v1[0], v1[1]); w.w = cvt_pk_bf16(v1[2], v1[3]);
                    *(u32x4*)(dst + (size_t)(row0 + ai * HALF + m * 16) * ldc + ct + c) = w;
                }
        }
    }
};
struct EpiFma {
    static constexpr bool PERM = true, AFTER_DRAIN = false;
    bf16_t* O; int ldc; const bf16_t* mul; int ldmul, mcol; const bf16_t* add; int ldadd;
    __device__ __forceinline__ void operator()(const f32x4 (&acc)[2][2][4][2], const Unit& u, int wr, int wc, int fr, int fq) const {
        const int row0 = u.pm * BM + wr * 64 + fr, c0 = u.pn * BM + wc * 32 + 8 * fq;
#pragma unroll
        for (int ai = 0; ai < 2; ++ai) {
            u32x4 gv[4][2], av[4][2];
#pragma unroll
            for (int m = 0; m < 4; ++m)
#pragma unroll
                for (int bj = 0; bj < 2; ++bj) { const size_t row = (size_t)(row0 + ai * HALF + m * 16); const int c = c0 + bj * HALF;
                    gv[m][bj] = __builtin_nontemporal_load((const u32x4*)(mul + row * ldmul + mcol + c));
                    av[m][bj] = add ? *(const u32x4*)(add + row * ldadd + c) : (u32x4){0u, 0u, 0u, 0u}; }
#pragma unroll
            for (int m = 0; m < 4; ++m) {
                const size_t row = (size_t)(row0 + ai * HALF + m * 16);
#pragma unroll
                for (int bj = 0; bj < 2; ++bj) {
                    const int c = c0 + bj * HALF;
                    const u32x4 g = gv[m][bj], a = av[m][bj];
                    f32x4 v0 = acc[ai][bj][m][0], v1 = acc[ai][bj][m][1];
                    v0[0] = v0[0] * bf_lo(g.x) + bf_lo(a.x); v0[1] = v0[1] * bf_hi(g.x) + bf_hi(a.x); v0[2] = v0[2] * bf_lo(g.y) + bf_lo(a.y); v0[3] = v0[3] * bf_hi(g.y) + bf_hi(a.y);
                    v1[0] = v1[0] * bf_lo(g.z) + bf_lo(a.z); v1[1] = v1[1] * bf_hi(g.z) + bf_hi(a.z); v1[2] = v1[2] * bf_lo(g.w) + bf_lo(a.w); v1[3] = v1[3] * bf_hi(g.w) + bf_hi(a.w);
                    u32x4 w; w.x = cvt_pk_bf16(v0[0], v0[1]); w.y = cvt_pk_bf16(v0[2], v0[3]); w.z = cvt_pk_bf16(v1[0], v1[1]); w.w = cvt_pk_bf16(v1[2], v1[3]);
                    *(u32x4*)(O + row * ldc + c) = w;
                }
            }
        }
    }
};
struct EpiResF32 {
    static constexpr bool PERM = false, AFTER_DRAIN = false;
    const float* base; float* out; int ldc; bool nt_store;
    __device__ __forceinline__ void operator()(const f32x4 (&acc)[2][2][4][2], const Unit& u, int wr, int wc, int fr, int fq) const {
        const int row0 = u.pm * BM + wr * 64 + fr, c0 = u.pn * BM + wc * 32 + 4 * fq;
#pragma unroll
        for (int ai = 0; ai < 2; ++ai) {
            f32x4 b[4][2][2];
#pragma unroll
            for (int m = 0; m < 4; ++m)
#pragma unroll
                for (int bj = 0; bj < 2; ++bj)
#pragma unroll
                    for (int n = 0; n < 2; ++n) b[m][bj][n] = __builtin_nontemporal_load((const f32x4*)(base + (size_t)(row0 + ai * HALF + m * 16) * ldc + c0 + bj * HALF + n * 16));
#pragma unroll
            for (int m = 0; m < 4; ++m) {
                const size_t off = (size_t)(row0 + ai * HALF + m * 16) * ldc + c0;
#pragma unroll
                for (int bj = 0; bj < 2; ++bj)
#pragma unroll
                    for (int n = 0; n < 2; ++n) {
                        if (nt_store) __builtin_nontemporal_store(b[m][bj][n] + acc[ai][bj][m][n], (f32x4*)(out + off + bj * HALF + n * 16));
                        else *(f32x4*)(out + off + bj * HALF + n * 16) = b[m][bj][n] + acc[ai][bj][m][n]; }
            }
        }
    }
};

typedef unsigned u32x2 __attribute__((ext_vector_type(2)));

struct EpiQ {
    static constexpr bool PERM = true, AFTER_DRAIN = false;
    bf16_t* qf; const float* gq; const float* cst; const float* snt; PG8_LAS float* part;
    __device__ __forceinline__ void operator()(const f32x4 (&acc)[2][2][4][2], const Unit& u, int wr, int wc, int fr, int fq) const {
        const int h = u.pn, row0 = u.pm * BM + wr * 64 + fr; const bool ropew = wc < 2;
#pragma unroll
        for (int ai = 0; ai < 2; ++ai)
#pragma unroll
            for (int m = 0; m < 4; ++m) { float s = 0.f;
#pragma unroll
                for (int n = 0; n < 2; ++n) { const f32x4 x = acc[ai][0][m][n]; s += (x[0] * x[0] + x[1] * x[1]) + (x[2] * x[2] + x[3] * x[3]);
                    if (ropew) { const f32x4 y = acc[ai][1][m][n]; s += (y[0] * y[0] + y[1] * y[1]) + (y[2] * y[2] + y[3] * y[3]); } }
                s = sum_rows4(s);
                if (fq == 0) part[(wr * 4 + wc) * 128 + ai * 64 + m * 16 + fr] = s; }
        asm volatile("s_waitcnt lgkmcnt(0)" ::: "memory"); __builtin_amdgcn_s_barrier(); asm volatile("" ::: "memory");
        const int cn = 32 * wc + 8 * fq, i0 = ropew ? 16 * wc + 4 * fq : 0;
        const f32x4 g0 = *(const f32x4*)(gq + cn), g1 = *(const f32x4*)(gq + cn + 4), gr1 = *(const f32x4*)(gq + 128 + i0), gr2 = *(const f32x4*)(gq + 160 + i0);
#pragma unroll
        for (int ai = 0; ai < 2; ++ai) {
            f32x4 cv[4], sv[4];
            if (ropew) {
#pragma unroll
                for (int m = 0; m < 4; ++m) { const size_t row = (size_t)(row0 + ai * HALF + m * 16); cv[m] = *(const f32x4*)(cst + row * 32 + i0); sv[m] = *(const f32x4*)(snt + row * 32 + i0); }
            }
#pragma unroll
            for (int m = 0; m < 4; ++m) { const int r128 = ai * 64 + m * 16 + fr;
                const float tot = (part[(wr * 4 + 0) * 128 + r128] + part[(wr * 4 + 1) * 128 + r128]) + (part[(wr * 4 + 2) * 128 + r128] + part[(wr * 4 + 3) * 128 + r128]);
                const float rq = rsqrtf(tot * (1.f / 192.f) + 1e-6f);
                const size_t row = (size_t)(row0 + ai * HALF + m * 16); bf16_t* qrow = qf + row * 3072 + h * 192;
                const f32x4 v0 = acc[ai][0][m][0] * rq * g0, v1 = acc[ai][0][m][1] * rq * g1;
                u32x4 w; w.x = cvt_pk_bf16(v0[0], v0[1]); w.y = cvt_pk_bf16(v0[2], v0[3]); w.z = cvt_pk_bf16(v1[0], v1[1]); w.w = cvt_pk_bf16(v1[2], v1[3]);
                *(u32x4*)(qrow + cn) = w;
                if (ropew) { const f32x4 x1 = acc[ai][1][m][0] * rq * gr1, x2 = acc[ai][1][m][1] * rq * gr2;
                    const f32x4 c4 = cv[m], s4 = sv[m];
                    const f32x4 o1 = x1 * c4 - x2 * s4, o2 = x2 * c4 + x1 * s4;
                    u32x2 a; a.x = cvt_pk_bf16(o1[0], o1[1]); a.y = cvt_pk_bf16(o1[2], o1[3]); *(u32x2*)(qrow + 128 + i0) = a;
                    u32x2 b; b.x = cvt_pk_bf16(o2[0], o2[1]); b.y = cvt_pk_bf16(o2[2], o2[3]); *(u32x2*)(qrow + 160 + i0) = b; }
            }
        }
    }
};
struct EpiKV {
    static constexpr bool PERM = true, AFTER_DRAIN = false;
    bf16_t* kf; bf16_t* vdst; const float* gk; const float* krr; const float* krss; PG8_LAS float* part;
    __device__ __forceinline__ void operator()(const f32x4 (&acc)[2][2][4][2], const Unit& u, int wr, int wc, int fr, int fq) const {
        const int h = u.pn, row0 = u.pm * BM + wr * 64 + fr;
#pragma unroll
        for (int ai = 0; ai < 2; ++ai)
#pragma unroll
            for (int m = 0; m < 4; ++m) { float s = 0.f;
#pragma unroll
                for (int n = 0; n < 2; ++n) { const f32x4 x = acc[ai][0][m][n]; s += (x[0] * x[0] + x[1] * x[1]) + (x[2] * x[2] + x[3] * x[3]); }
                s = sum_rows4(s);
                if (fq == 0) part[(wr * 4 + wc) * 128 + ai * 64 + m * 16 + fr] = s; }
        asm volatile("s_waitcnt lgkmcnt(0)" ::: "memory"); __builtin_amdgcn_s_barrier(); asm volatile("" ::: "memory");
        const int cn = 32 * wc + 8 * fq, i0 = 16 * wc + 4 * fq;
        const f32x4 g0 = *(const f32x4*)(gk + cn), g1 = *(const f32x4*)(gk + cn + 4);
        f32x4 krv[2][4]; float kss[2][4];
#pragma unroll
        for (int ai = 0; ai < 2; ++ai)
#pragma unroll
            for (int m = 0; m < 4; ++m) { const size_t row = (size_t)(row0 + ai * HALF + m * 16); krv[ai][m] = *(const f32x4*)(krr + row * 64 + i0); kss[ai][m] = krss[row]; }
#pragma unroll
        for (int ai = 0; ai < 2; ++ai)
#pragma unroll
            for (int m = 0; m < 4; ++m) { const int r128 = ai * 64 + m * 16 + fr;
                const size_t row = (size_t)(row0 + ai * HALF + m * 16);
                const float tot = (part[(wr * 4 + 0) * 128 + r128] + part[(wr * 4 + 1) * 128 + r128]) + (part[(wr * 4 + 2) * 128 + r128] + part[(wr * 4 + 3) * 128 + r128]) + kss[ai][m];
                const float rk = rsqrtf(tot * (1.f / 192.f) + 1e-6f);
                bf16_t* krow = kf + row * 3072 + h * 192;
                const f32x4 v0 = acc[ai][0][m][0] * rk * g0, v1 = acc[ai][0][m][1] * rk * g1;
                u32x4 w; w.x = cvt_pk_bf16(v0[0], v0[1]); w.y = cvt_pk_bf16(v0[2], v0[3]); w.z = cvt_pk_bf16(v1[0], v1[1]); w.w = cvt_pk_bf16(v1[2], v1[3]);
                *(u32x4*)(krow + cn) = w;
                const f32x4 kr4 = krv[ai][m] * rk;
                u32x2 a; a.x = cvt_pk_bf16(kr4[0], kr4[1]); a.y = cvt_pk_bf16(kr4[2], kr4[3]); *(u32x2*)(krow + 128 + i0) = a;
                const f32x4 y0 = acc[ai][1][m][0], y1 = acc[ai][1][m][1];
                u32x4 z; z.x = cvt_pk_bf16(y0[0], y0[1]); z.y = cvt_pk_bf16(y0[2], y0[3]); z.z = cvt_pk_bf16(y1[0], y1[1]); z.w = cvt_pk_bf16(y1[2], y1[3]);
                *(u32x4*)(vdst + row * 4096 + h * 256 + 128 + cn) = z;
            }
    }
};
struct EpiResNorm {
    static constexpr bool PERM = false, AFTER_DRAIN = false;
    const float* base; float* out; bf16_t* hb; float* rowss; int ldc;
    __device__ __forceinline__ void operator()(const f32x4 (&acc)[2][2][4][2], const Unit& u, int wr, int wc, int fr, int fq) const {
        const int row0 = u.pm * BM + wr * 64 + fr, c0 = u.pn * BM + wc * 32 + 4 * fq;
#pragma unroll
        for (int ai = 0; ai < 2; ++ai) {
            f32x4 b[4][2][2];
#pragma unroll
            for (int m = 0; m < 4; ++m)
#pragma unroll
                for (int bj = 0; bj < 2; ++bj)
#pragma unroll
                    for (int n = 0; n < 2; ++n) b[m][bj][n] = __builtin_nontemporal_load((const f32x4*)(base + (size_t)(row0 + ai * HALF + m * 16) * ldc + c0 + bj * HALF + n * 16));
#pragma unroll
            for (int m = 0; m < 4; ++m) {
                const int row = row0 + ai * HALF + m * 16; const size_t off = (size_t)row * ldc + c0; float ss = 0.f;
#pragma unroll
                for (int bj = 0; bj < 2; ++bj)
#pragma unroll
                    for (int n = 0; n < 2; ++n) { const f32x4 h = b[m][bj][n] + acc[ai][bj][m][n];
                        *(f32x4*)(out + off + bj * HALF + n * 16) = h; ss += (h[0] * h[0] + h[1] * h[1]) + (h[2] * h[2] + h[3] * h[3]);
                        u32x2 w; w.x = cvt_pk_bf16(h[0], h[1]); w.y = cvt_pk_bf16(h[2], h[3]); *(u32x2*)(hb + off + bj * HALF + n * 16) = w; }
                ss = sum_rows4(ss);
                if (fq == 0) unsafeAtomicAdd(rowss + row, ss);
            }
        }
    }
};
__device__ __forceinline__ float dpp_ror1(float v) { return __builtin_bit_cast(float, __builtin_amdgcn_update_dpp(0, __builtin_bit_cast(int, v), 0x121, 0xf, 0xf, false)); }
__device__ __forceinline__ float dpp_ror2(float v) { return __builtin_bit_cast(float, __builtin_amdgcn_update_dpp(0, __builtin_bit_cast(int, v), 0x122, 0xf, 0xf, false)); }
__device__ __forceinline__ float fma_s(float a, float b, float c) { float r; asm("v_fma_f32 %0, %1, %2, %3" : "=v"(r) : "v"(a), "v"(b), "v"(c)); return r; }
struct EpiUpGate {
    static constexpr bool PERM = true, AFTER_DRAIN = false;
    bf16_t* gout; const float* fw; const float* fb; PG8_LAS float* xch; const float* rowss;
    __device__ __forceinline__ void operator()(const f32x4 (&acc)[2][2][4][2], const Unit& u, int wr, int wc, int fr, int fq) const {
        constexpr int FF = 5632;
        const int b = u.pm / 17, ti = u.pm % 17, t0 = 254 * ti - 2;
        const int colx = wc * 32 + fq * 8, j0 = u.pn * 128 + colx;
        float r2v[2][4]; f32x4 wts[2][2][4];
#pragma unroll
        for (int ai = 0; ai < 2; ++ai)
#pragma unroll
            for (int m = 0; m < 4; ++m) { int t = t0 + ai * HALF + wr * 64 + m * 16 + fr; t = t < 0 ? 0 : (t > 4095 ? 4095 : t); r2v[ai][m] = rowss[b * 4096 + t]; }
#pragma unroll
        for (int bj = 0; bj < 2; ++bj) { const int c = bj * FF + j0;
            wts[0][bj][0] = *(const f32x4*)(fw + c); wts[0][bj][1] = *(const f32x4*)(fw + 2 * FF + c); wts[0][bj][2] = *(const f32x4*)(fw + 4 * FF + c); wts[0][bj][3] = *(const f32x4*)(fb + c); }
#pragma unroll
        for (int ai = 0; ai < 2; ++ai)
#pragma unroll
            for (int m = 0; m < 4; ++m) r2v[ai][m] = rsqrtf(r2v[ai][m] * (1.f / 2048.f) + 1e-6f);
        if (fr >= 14) {
#pragma unroll
            for (int ai = 0; ai < 2; ++ai)
#pragma unroll
                for (int bj = 0; bj < 2; ++bj)
#pragma unroll
                    for (int n = 0; n < 2; ++n) *(PG8_LAS f32x4*)(xch + (((ai * 2 + wr) * 2 + (fr - 14)) * 256 + bj * 128 + colx + n * 4)) = acc[ai][bj][3][n] * r2v[ai][3];
        }
        asm volatile("s_waitcnt lgkmcnt(0)" ::: "memory"); __builtin_amdgcn_s_barrier(); asm volatile("" ::: "memory");
        const bool first = (ti == 0);
        const f32x4 zero4 = (f32x4){0.f, 0.f, 0.f, 0.f};
#pragma unroll
        for (int n = 0; n < 2; ++n) {
            const f32x4 w0[2] = {wts[n][0][0], wts[n][1][0]}, w1[2] = {wts[n][0][1], wts[n][1][1]}, w2[2] = {wts[n][0][2], wts[n][1][2]}, bb[2] = {wts[n][0][3], wts[n][1][3]};
#pragma unroll
            for (int ai = 0; ai < 2; ++ai) {
                f32x4 pr1[2] = {zero4, zero4}, pr2[2] = {zero4, zero4};
                const bool hasprev = (wr == 1) || (ai == 1);
                const int pg = (wr == 1) ? ai * 2 : (ai - 1) * 2 + 1;
                if (hasprev && fr < 2) {
#pragma unroll
                    for (int bj = 0; bj < 2; ++bj) {
                        pr2[bj] = *(const PG8_LAS f32x4*)(xch + ((pg * 2 + fr) * 256 + bj * 128 + colx + n * 4));
                        pr1[bj] = *(const PG8_LAS f32x4*)(xch + ((pg * 2 + 1) * 256 + bj * 128 + colx + n * 4)); }
                }
#pragma unroll
                for (int m = 0; m < 4; ++m) {
                    f32x4 cur[2] = {acc[ai][0][m][n] * r2v[ai][m], acc[ai][1][m][n] * r2v[ai][m]};
                    if (first && ai == 0 && wr == 0 && m == 0 && fr < 2) { cur[0] = zero4; cur[1] = zero4; }
                    f32x4 r1[2], r2[2], av[2];
#pragma unroll
                    for (int bj = 0; bj < 2; ++bj)
#pragma unroll
                        for (int e = 0; e < 4; ++e) { r1[bj][e] = dpp_ror1(cur[bj][e]); r2[bj][e] = dpp_ror2(cur[bj][e]); }
#pragma unroll
                    for (int bj = 0; bj < 2; ++bj)
#pragma unroll
                        for (int e = 0; e < 4; ++e) { const float p1 = fr >= 1 ? r1[bj][e] : pr1[bj][e], p2 = fr >= 2 ? r2[bj][e] : pr2[bj][e];
                            av[bj][e] = fma_s(w0[bj][e], p2, fma_s(w1[bj][e], p1, fma_s(w2[bj][e], cur[bj][e], bb[bj][e]))); }
                    float o[4];
#pragma unroll
                    for (int e = 0; e < 4; ++e) o[e] = av[0][e] * sigmoid_f(av[0][e]) * av[1][e];
                    const int lr = ai * HALF + wr * 64 + m * 16 + fr, t = t0 + lr;
                    if (lr >= 2 && t < 4096) { u32x2 w; w.x = cvt_pk_bf16(o[0], o[1]); w.y = cvt_pk_bf16(o[2], o[3]);
                        *(u32x2*)(gout + (size_t)(b * 4096 + t) * FF + j0 + n * 4) = w; }
                    pr1[0] = r1[0]; pr1[1] = r1[1]; pr2[0] = r2[0]; pr2[1] = r2[1];
                }
                if (n == 0 && ai == 0) {
#pragma unroll
                    for (int bj = 0; bj < 2; ++bj) { const int c = bj * FF + j0 + 4;
                        wts[1][bj][0] = *(const f32x4*)(fw + c); wts[1][bj][1] = *(const f32x4*)(fw + 2 * FF + c); wts[1][bj][2] = *(const f32x4*)(fw + 4 * FF + c); wts[1][bj][3] = *(const f32x4*)(fb + c); }
                }
            }
        }
    }
};
template <class Epi, class Sched, bool ALIGN_EPI = false, bool SP2 = false>
__device__ __forceinline__ void gemm_phase(PG8_LAS unsigned char* lds, const Gemm g, const Sched& S, const Epi& E) {
    int tid_ = threadIdx.x; asm volatile("" : "+v"(tid_));
    const int tid = tid_, wid = __builtin_amdgcn_readfirstlane(tid >> 6), lane = tid & 63, wr = wid >> 2, wc = wid & 3, fr = lane & 15, fq = lane >> 4;
    const int K = g.K, nt = K / BK;
    unsigned voffA[2], voffB[2];
#pragma unroll
    for (int i = 0; i < 2; ++i) { int R, C; stage_rc(tid * 16 + i * 8192, R, C); const int Rb = Epi::PERM ? ((R & ~31) + perm32(R & 31)) : R;
        voffA[i] = (unsigned)(R * K + C) * 2u; voffB[i] = (unsigned)(Rb * K + C) * 2u; }
    const size_t kstep = (size_t)(BK * 2);
    const size_t hstep = (size_t)HALF * K * 2;
    const size_t tstep = 2 * hstep;
    const unsigned ldsw = (unsigned)wid * 1024u;
    const int aoff = lds_byte(wr * 64 + fr, fq * 8), boff = lds_byte(wc * 32 + fr, fq * 8);
#define PG8_SA(b, h) (((b) * 2 + (h)) * HTB)
#define PG8_SB(b, h) ((4 + (b) * 2 + (h)) * HTB)
#define PG8_STAGE(bufoff, gbase, voff) do { _Pragma("unroll") for (int _i = 0; _i < 2; ++_i) \
        __builtin_amdgcn_global_load_lds((const unsigned*)((const char*)(gbase) + (voff)[_i]), (PG8_LAS unsigned*)(lds + (bufoff) + ldsw + _i * 8192), 16, 0, 0); } while (0)
#define PG8_LDA(dst, b, h) do { _Pragma("unroll") for (int m = 0; m < 4; ++m) _Pragma("unroll") for (int k = 0; k < 2; ++k) dst[m][k] = *(const PG8_LAS bf16x8*)(lds + PG8_SA(b, h) + aoff + m * 2048 + k * 1024); } while (0)
#define PG8_LDB(dst, b, h) do { _Pragma("unroll") for (int n = 0; n < 2; ++n) _Pragma("unroll") for (int k = 0; k < 2; ++k) dst[n][k] = *(const PG8_LAS bf16x8*)(lds + PG8_SB(b, h) + boff + n * 2048 + k * 1024); } while (0)
#define PG8_MMA(ai, bj, At, Bt) do { __builtin_amdgcn_s_setprio(1); _Pragma("unroll") for (int m = 0; m < 4; ++m) _Pragma("unroll") for (int n = 0; n < 2; ++n) _Pragma("unroll") for (int k = 0; k < 2; ++k) \
        acc[ai][bj][m][n] = __builtin_amdgcn_mfma_f32_16x16x32_bf16(Bt[n][k], At[m][k], acc[ai][bj][m][n], 0, 0, 0); __builtin_amdgcn_s_setprio(0); } while (0)
#define PG8_WAIT_V(n) asm volatile("s_waitcnt vmcnt(" #n ")" ::: "memory")
#define PG8_WAIT_L(n) asm volatile("s_waitcnt lgkmcnt(" #n ")" ::: "memory")
#define PG8_BAR __builtin_amdgcn_s_barrier()
#define PG8_SCHED __builtin_amdgcn_sched_barrier(0)
    Unit cur, nxt; int ui = 0;
    if (!S.next(0, cur)) return;
    f32x4 acc[2][2][4][2];
#pragma unroll
    for (int a = 0; a < 2; ++a)
#pragma unroll
        for (int b = 0; b < 2; ++b)
#pragma unroll
            for (int m = 0; m < 4; ++m)
#pragma unroll
                for (int n = 0; n < 2; ++n) acc[a][b][m][n] = (f32x4){0.f, 0.f, 0.f, 0.f};
    bf16x8 At[4][2], B0[2][2], B1[2][2];
    const char* cA = (const char*)g.A + (long)S.a_row(cur) * (long)(K * 2); const char* cB = (const char*)g.Bt + (size_t)cur.pn * tstep;
    S.a_ready(cur);
    if constexpr (SP2) {
        PG8_STAGE(PG8_SB(0, 0), cB, voffB); PG8_STAGE(PG8_SB(0, 1), cB + hstep, voffB); PG8_STAGE(PG8_SA(0, 0), cA, voffA); PG8_STAGE(PG8_SA(0, 1), cA + hstep, voffA);
        if (wr == 1) PG8_BAR;
        PG8_WAIT_V(2); PG8_BAR;
        PG8_STAGE(PG8_SB(1, 0), cB + kstep, voffB); PG8_STAGE(PG8_SA(1, 0), cA + kstep, voffA); PG8_STAGE(PG8_SB(1, 1), cB + hstep + kstep, voffB);
        PG8_WAIT_V(6); PG8_BAR;
    } else {
        PG8_STAGE(PG8_SB(0, 0), cB, voffB); PG8_STAGE(PG8_SA(0, 0), cA, voffA); PG8_STAGE(PG8_SB(0, 1), cB + hstep, voffB); PG8_STAGE(PG8_SA(0, 1), cA + hstep, voffA);
        if (wr == 1) PG8_BAR;
        PG8_WAIT_V(4); PG8_BAR;
        PG8_STAGE(PG8_SB(1, 0), cB + kstep, voffB); PG8_STAGE(PG8_SA(1, 0), cA + kstep, voffA); PG8_STAGE(PG8_SB(1, 1), cB + hstep + kstep, voffB);
        PG8_WAIT_V(6); PG8_BAR;
    }
    for (;;) {
        const bool has_next = S.next(ui + 1, nxt);
        const char* nA = has_next ? (const char*)g.A + (long)S.a_row(nxt) * (long)(K * 2) : cA; const char* nB = has_next ? (const char*)g.Bt + (size_t)nxt.pn * tstep : cB;
        for (int t = 0; t < nt; t += 2) {
            const bool last = (t == nt - 2);
            const char* a1 = cA + (size_t)(t + 1) * kstep;
            const char* a2 = last ? nA : cA + (size_t)(t + 2) * kstep; const char* b2 = last ? nB : cB + (size_t)(t + 2) * kstep;
            const char* a3 = a2 + kstep; const char* b3 = b2 + kstep;
            if (last && has_next) S.a_ready(nxt);
            if constexpr (SP2) {
            PG8_LDB(B0, 0, 0); PG8_LDB(B1, 0, 1); PG8_SCHED; PG8_LDA(At, 0, 0); PG8_STAGE(PG8_SA(1, 1), a1 + hstep, voffA);
            PG8_WAIT_V(8); PG8_WAIT_L(0); PG8_BAR; PG8_MMA(0, 0, At, B0); PG8_MMA(0, 1, At, B1); PG8_BAR; PG8_SCHED;
            PG8_LDA(At, 0, 1); PG8_STAGE(PG8_SB(0, 0), b2, voffB); PG8_STAGE(PG8_SB(0, 1), b2 + hstep, voffB); PG8_STAGE(PG8_SA(0, 0), a2, voffA);
            PG8_WAIT_V(8); PG8_WAIT_L(0); PG8_BAR; PG8_MMA(1, 0, At, B0); PG8_MMA(1, 1, At, B1); PG8_BAR; PG8_SCHED;
            PG8_LDB(B0, 1, 0); PG8_LDB(B1, 1, 1); PG8_SCHED; PG8_LDA(At, 1, 0); PG8_STAGE(PG8_SA(0, 1), a2 + hstep, voffA);
            PG8_WAIT_V(8); PG8_WAIT_L(0); PG8_BAR; PG8_MMA(0, 0, At, B0); PG8_MMA(0, 1, At, B1); PG8_BAR; PG8_SCHED;
            PG8_LDA(At, 1, 1); PG8_STAGE(PG8_SB(1, 0), b3, voffB); PG8_STAGE(PG8_SB(1, 1), b3 + hstep, voffB); PG8_STAGE(PG8_SA(1, 0), a3, voffA);
            PG8_WAIT_V(8); PG8_WAIT_L(0); PG8_BAR; PG8_MMA(1, 0, At, B0); PG8_MMA(1, 1, At, B1); PG8_BAR; PG8_SCHED;
            } else {
            PG8_LDB(B0, 0, 0); PG8_SCHED; PG8_LDA(At, 0, 0); PG8_STAGE(PG8_SA(1, 1), a1 + hstep, voffA);
            PG8_WAIT_L(8); PG8_BAR; PG8_WAIT_L(0); PG8_MMA(0, 0, At, B0); PG8_BAR; PG8_SCHED;
            PG8_LDB(B1, 0, 1); PG8_STAGE(PG8_SB(0, 0), b2, voffB);
            PG8_BAR; PG8_WAIT_L(0); PG8_MMA(0, 1, At, B1); PG8_BAR;
            PG8_LDA(At, 0, 1); PG8_STAGE(PG8_SA(0, 0), a2, voffA);
            PG8_BAR; PG8_WAIT_L(0); PG8_MMA(1, 0, At, B0); PG8_BAR; PG8_SCHED;
            PG8_STAGE(PG8_SB(0, 1), b2 + hstep, voffB);
            PG8_WAIT_V(6); PG8_BAR; PG8_MMA(1, 1, At, B1); PG8_BAR;
            PG8_LDB(B0, 1, 0); PG8_SCHED; PG8_LDA(At, 1, 0); PG8_STAGE(PG8_SA(0, 1), a2 + hstep, voffA);
            PG8_WAIT_L(8); PG8_BAR; PG8_WAIT_L(0); PG8_MMA(0, 0, At, B0); PG8_BAR; PG8_SCHED;
            PG8_LDB(B1, 1, 1); PG8_STAGE(PG8_SB(1, 0), b3, voffB);
            PG8_BAR; PG8_WAIT_L(0); PG8_MMA(0, 1, At, B1); PG8_BAR;
            PG8_LDA(At, 1, 1); PG8_STAGE(PG8_SA(1, 0), a3, voffA);
            PG8_BAR; PG8_WAIT_L(0); PG8_MMA(1, 0, At, B0); PG8_BAR; PG8_SCHED;
            PG8_STAGE(PG8_SB(1, 1), b3 + hstep, voffB);
            PG8_WAIT_V(6); PG8_BAR; PG8_MMA(1, 1, At, B1); PG8_BAR;
            }
        }
        if constexpr (ALIGN_EPI) { if (wr == 0) PG8_BAR; }
        if constexpr (!Epi::AFTER_DRAIN) { E(acc, cur, wr, wc, fr, fq); S.done(cur); }
        if (!has_next) break;
#pragma unroll
        for (int a = 0; a < 2; ++a)
#pragma unroll
            for (int b = 0; b < 2; ++b)
#pragma unroll
                for (int m = 0; m < 4; ++m)
#pragma unroll
                    for (int n = 0; n < 2; ++n) acc[a][b][m][n] = (f32x4){0.f, 0.f, 0.f, 0.f};
        cur = nxt; cA = nA; cB = nB; ++ui;
        if constexpr (ALIGN_EPI) { if (wr == 1) PG8_BAR; }
    }
    PG8_WAIT_V(0);
    if constexpr (!ALIGN_EPI) { if (wr == 0) PG8_BAR; }
    PG8_BAR;
    if constexpr (Epi::AFTER_DRAIN) { E.fused(acc, cur, wr, wc, fr, fq, lds, wid, lane); S.done(cur); }
#undef PG8_SA
#undef PG8_SB
#undef PG8_STAGE
#undef PG8_LDA
#undef PG8_LDB
#undef PG8_MMA
#undef PG8_WAIT_V
#undef PG8_WAIT_L
#undef PG8_BAR
#undef PG8_SCHED
}
}
namespace att {
using bf16 = __hip_bfloat16;
typedef short bf16x8 __attribute__((ext_vector_type(8)));
typedef short s16x4 __attribute__((ext_vector_type(4)));
typedef float f32x16 __attribute__((ext_vector_type(16)));
typedef float f32x4 __attribute__((ext_vector_type(4)));
typedef unsigned u32x4 __attribute__((ext_vector_type(4)));
constexpr int DK = 192, DV = 128;
constexpr int QS = 3072, KS = 3072, VS = 4096, OS = 2048;
constexpr int SEQ = 4096, NH = 16;
constexpr float SCALE = 0.07216878364870322f;
constexpr float THR = 8.f;
constexpr int NW = 8, QBLK = 32, KVBLK = 64, QB = NW * QBLK;
constexpr int SHM_V = KVBLK * DV * 2, SHM_K = KVBLK * DK * 2;
constexpr int LDS_Q = 2 * SHM_V + 2 * SHM_K + NW * 64 * 4;
constexpr int NQR = 6, NQL_ = 12 - NQR;
constexpr int LDS_BYTES = LDS_Q + NW * NQL_ * 64 * 16;
#define KSWZ(row, colB) ((row) * 384 + ((colB) ^ ((((row) >> 1) & 7) << 4)))
#define SBAR() __builtin_amdgcn_sched_barrier(0)
__device__ __forceinline__ int v_st(int k, int c) { const int kk = (k & ~0xC) | ((k & 4) << 1) | ((k & 8) >> 1); return ((kk >> 3) * 4 + (c >> 5)) * 512 + ((kk & 7) * 32 + (c & 31)) * 2; }
__device__ __forceinline__ int v_rd_base(int lane) { return ((lane & 3) << 3) | (((lane >> 2) & 3) << 6) | (((lane >> 4) & 1) << 5) | (((lane >> 5) & 1) << 8); }
constexpr int v_rd_off(int d0, int ks, int half) { return d0 * 512 + ks * 4096 + half * 2048; }
__device__ __forceinline__ int crow(int r, int hi) { return (r & 3) + 8 * (r >> 2) + 4 * hi; }
__device__ __forceinline__ unsigned cvtpk(float lo, float hi) { unsigned r; asm volatile("v_cvt_pk_bf16_f32 %0, %1, %2" : "=v"(r) : "v"(lo), "v"(hi)); return r; }
__device__ __forceinline__ bf16x8 load8(const bf16* p) { return *reinterpret_cast<const bf16x8*>(p); }
__device__ __forceinline__ void mask_tile(f32x16& p0, f32x16& p1, int dq, unsigned W) {
    const float NEG = -__builtin_inff();
#pragma unroll
    for (int r = 0; r < 16; ++r) {
        const int c = (r & 3) + 8 * (r >> 2);
        if ((unsigned)(dq - c) >= W) p0[r] = NEG;
        if ((unsigned)(dq - c - 32) >= W) p1[r] = NEG;
    }
}
__device__ __forceinline__ void partialSM(f32x16& p0, f32x16& p1, float& m_reg, float& mn, float& alpha) {
    float pmax = p0[0]; for (int r = 1; r < 16; ++r) pmax = fmaxf(pmax, p0[r]); for (int r = 0; r < 16; ++r) pmax = fmaxf(pmax, p1[r]);
    { auto rr = __builtin_amdgcn_permlane32_swap(__float_as_uint(pmax), __float_as_uint(pmax), false, false);
      pmax = fmaxf(__uint_as_float(rr[0]), __uint_as_float(rr[1])); }
    constexpr float C2 = 1.4426950408889634f * SCALE;
    if (__builtin_expect(__all((pmax - m_reg) * SCALE <= THR), 1)) { mn = m_reg; alpha = 1.f; }
    else { mn = fmaxf(m_reg, pmax); alpha = __builtin_amdgcn_exp2f((m_reg - mn) * C2); m_reg = mn; }
    const float mnL = -mn * C2;
    for (int r = 0; r < 16; ++r) p0[r] = fmaf(p0[r], C2, mnL); for (int r = 0; r < 16; ++r) p1[r] = fmaf(p1[r], C2, mnL);
    for (int r = 0; r < 16; ++r) p0[r] = __builtin_amdgcn_exp2f(p0[r]);
}
__device__ __forceinline__ void finishSM(f32x16& p0, f32x16& p1, float alpha, float& l_reg, bf16x8& pa0, bf16x8& pa1, bf16x8& pa2, bf16x8& pa3) {
    for (int r = 0; r < 16; ++r) p1[r] = __builtin_amdgcn_exp2f(p1[r]);
    float ps = 0; for (int r = 0; r < 16; ++r) ps += p0[r]; for (int r = 0; r < 16; ++r) ps += p1[r];
    { auto rr = __builtin_amdgcn_permlane32_swap(__float_as_uint(ps), __float_as_uint(ps), false, false);
      ps = __uint_as_float(rr[0]) + __uint_as_float(rr[1]); }
    l_reg = l_reg * alpha + ps;
#define PK4(P, B_, OUT) do { unsigned a0 = cvtpk(P[B_+0], P[B_+1]), a1 = cvtpk(P[B_+2], P[B_+3]);                          \
        unsigned b0 = cvtpk(P[B_+4], P[B_+5]), b1 = cvtpk(P[B_+6], P[B_+7]);                                             \
        auto r0 = __builtin_amdgcn_permlane32_swap(a0, b0, false, false); auto r1 = __builtin_amdgcn_permlane32_swap(a1, b1, false, false); \
        u32x4 w = {r0[0], r1[0], r0[1], r1[1]}; OUT = *reinterpret_cast<bf16x8*>(&w); } while (0)
    PK4(p0, 0, pa0); PK4(p0, 8, pa1); PK4(p1, 0, pa2); PK4(p1, 8, pa3);
#undef PK4
}
template <int KB>
__device__ __forceinline__ void qkt(f32x16& p0, f32x16& p1, const char* K_lds, int r32, int hi, const bf16x8* qr, const char* q_lds) {
    p0 = f32x16{}; p1 = f32x16{};
    const char* kb[4];
#pragma unroll
    for (int dd = 0; dd < 4; ++dd) kb[dd] = K_lds + KB * SHM_K + KSWZ(r32, (dd * 16 + hi * 8) * 2);
#pragma unroll
    for (int d0 = 0; d0 < 12; ++d0) { const char* a = kb[d0 & 3] + (d0 >> 2) * 128;
        bf16x8 b0 = *reinterpret_cast<const bf16x8*>(a);
        bf16x8 b1 = *reinterpret_cast<const bf16x8*>(a + 32 * 384);
        const bf16x8 qf = d0 < NQR ? qr[d0 < NQR ? d0 : 0] : *reinterpret_cast<const bf16x8*>(q_lds + (d0 - NQR) * 1024);
        p0 = __builtin_amdgcn_mfma_f32_32x32x16_bf16(b0, qf, p0, 0, 0, 0);
        p1 = __builtin_amdgcn_mfma_f32_32x32x16_bf16(b1, qf, p1, 0, 0, 0); }
}
template <int VB>
__device__ __forceinline__ void pv_tile(f32x16* o, int vb0, bf16x8 pa0, bf16x8 pa1, bf16x8 pa2, bf16x8 pa3) {
#define TRRD(dst, off) asm volatile("ds_read_b64_tr_b16 %0, %1 offset:%2" : "=&v"(dst) : "v"(vb0), "i"(off) : "memory")
#define PV_D0(d0) do { s16x4 l0, l1, l2, l3, h0, h1, h2, h3; constexpr int b_ = VB * SHM_V + v_rd_off(d0, 0, 0); \
        TRRD(l0, b_); TRRD(h0, b_ + 2048); TRRD(l1, b_ + 4096); TRRD(h1, b_ + 6144); TRRD(l2, b_ + 8192); TRRD(h2, b_ + 10240); TRRD(l3, b_ + 12288); TRRD(h3, b_ + 14336); \
        asm volatile("s_waitcnt lgkmcnt(0)" ::: "memory"); SBAR();   \
        o[d0] = __builtin_amdgcn_mfma_f32_32x32x16_bf16(pa0, (bf16x8){l0[0], l0[1], l0[2], l0[3], h0[0], h0[1], h0[2], h0[3]}, o[d0], 0, 0, 0);   \
        o[d0] = __builtin_amdgcn_mfma_f32_32x32x16_bf16(pa1, (bf16x8){l1[0], l1[1], l1[2], l1[3], h1[0], h1[1], h1[2], h1[3]}, o[d0], 0, 0, 0);   \
        o[d0] = __builtin_amdgcn_mfma_f32_32x32x16_bf16(pa2, (bf16x8){l2[0], l2[1], l2[2], l2[3], h2[0], h2[1], h2[2], h2[3]}, o[d0], 0, 0, 0);   \
        o[d0] = __builtin_amdgcn_mfma_f32_32x32x16_bf16(pa3, (bf16x8){l3[0], l3[1], l3[2], l3[3], h3[0], h3[1], h3[2], h3[3]}, o[d0], 0, 0, 0); } while (0)
    PV_D0(0); PV_D0(1); PV_D0(2); PV_D0(3);
#undef PV_D0
#undef TRRD
}
struct BlockRef { const bf16* Q; const bf16* K; const bf16* V; bf16* O; int P0; };
struct Seam { bf16x8 qr[NQR]; bf16x8 qt[NQL_]; bf16x8 st_v0, st_v1, st_k0, st_k1, st_k2; };
__device__ __forceinline__ int swa_jlo(int P0, int W) { const int lowk = P0 - W + 1; return lowk > 0 ? lowk / KVBLK : 0; }
#define VROW(p, k0, rr) ((p) + (size_t)((k0) + (rr)) * VS + sc)
#define KROW(p, k0) ((p) + (size_t)((k0) + kr_) * KS + kc_)
#define VMW() asm volatile("s_waitcnt vmcnt(0)" ::: "memory")
#define VMWN(n) asm volatile("s_waitcnt vmcnt(%0)" :: "i"(n) : "memory")
#define SLOAD_H(Kp, Vp, k0) do { S.st_v0 = load8(VROW(Vp, k0, sr)); S.st_v1 = load8(VROW(Vp, k0, 32 + sr));              \
                         S.st_k0 = load8(KROW(Kp, k0)); S.st_k1 = load8(KROW(Kp, k0) + 64); S.st_k2 = load8(KROW(Kp, k0) + 128); } while (0)
#define SWRITE_HK(bf) do { *(bf16x8*)(K_lds + (bf) * SHM_K + kws) = S.st_k0; *(bf16x8*)(K_lds + (bf) * SHM_K + kws + 128) = S.st_k1; *(bf16x8*)(K_lds + (bf) * SHM_K + kws + 256) = S.st_k2; } while (0)
#define SWRITE_HV(bf) do { *(bf16x8*)(V_lds + (bf) * SHM_V + vst0) = S.st_v0; *(bf16x8*)(V_lds + (bf) * SHM_V + vst1) = S.st_v1; } while (0)
#define SWRITE_H(bf) do { SWRITE_HV(bf); SWRITE_HK(bf); } while (0)
__device__ __forceinline__ void attn_prime(const BlockRef& cur, int W, char* lds, Seam& S) {
    int tid_ = threadIdx.x; asm volatile("" : "+v"(tid_));
    const int tid = tid_, wid = __builtin_amdgcn_readfirstlane(tid >> 6), lane = tid & 63, r32 = lane & 31, hi = lane >> 5;
    const int sr = tid >> 4, sc = (tid & 15) * 8, kr_ = tid >> 3, kc_ = (tid & 7) * 8, kws = KSWZ(kr_, kc_ * 2); char* K_lds = lds + 2 * SHM_V;
    const int kb0 = swa_jlo(cur.P0, W) * KVBLK;
#pragma unroll
    for (int d0 = 0; d0 < NQR; ++d0) S.qr[d0] = load8(cur.Q + (size_t)(wid * QBLK + r32) * QS + d0 * 16 + hi * 8);
#pragma unroll
    for (int d0 = 0; d0 < NQL_; ++d0) S.qt[d0] = load8(cur.Q + (size_t)(wid * QBLK + r32) * QS + (NQR + d0) * 16 + hi * 8);
    SLOAD_H(cur.K, cur.V, kb0); VMW(); SWRITE_HK(0);
    __syncthreads();
}
__device__ __forceinline__ void attn_block(const BlockRef& cur, const BlockRef& nxt, int skv, int W, char* lds, Seam& S) {
    int tid_ = threadIdx.x; asm volatile("" : "+v"(tid_));
    const int tid = tid_, wid = __builtin_amdgcn_readfirstlane(tid >> 6), lane = tid & 63, r32 = lane & 31, hi = lane >> 5;
    const int j_lo = swa_jlo(cur.P0, W);
    int j_hi = (cur.P0 + QB - 1) / KVBLK + 1; if (j_hi > skv / KVBLK) j_hi = skv / KVBLK;
    const int NT = j_hi - j_lo;
    const int kbn = swa_jlo(nxt.P0, W) * KVBLK;
    const int qlo = cur.P0 + wid * QBLK, qm = qlo + r32 - 4 * hi;
    char* V_lds = lds; char* K_lds = lds + 2 * SHM_V;
    float* ws = (float*)(lds + 2 * SHM_V + 2 * SHM_K) + wid * 64; float* li_l = ws, * al_l = ws + 32;
    float m_reg = -1e30f, l_reg = 0; f32x16 o[4] = {};
    const int sr = tid >> 4, sc = (tid & 15) * 8, vst0 = v_st(sr, sc), vst1 = v_st(32 + sr, sc);
    const int kr_ = tid >> 3, kc_ = (tid & 7) * 8, kws = KSWZ(kr_, kc_ * 2);
    const int vb0 = (int)(uintptr_t)V_lds + v_rd_base(lane);
    const bf16* Kh = cur.K; const bf16* Vh = cur.V;
#define RESC(a) do { if (__any((a) < 1.f)) { if (hi == 0) al_l[r32] = (a); asm volatile("s_waitcnt lgkmcnt(0)" ::: "memory");              \
                     for (int d_ = 0; d_ < 4; ++d_) for (int r = 0; r < 16; ++r) o[d_][r] *= al_l[crow(r, hi)]; } } while (0)
#define KBASE(t) ((j_lo + (t)) * KVBLK)
#define MASKT(P0_, P1_, t) do { const int kb_ = KBASE(t); if (kb_ + KVBLK - 1 > qlo || kb_ <= qlo + QBLK - 1 - W) mask_tile(P0_, P1_, qm - kb_, (unsigned)W); } while (0)
    constexpr int NQL = 12;
#define SEAM_K0() do { VMWN(NQL); SWRITE_HK(0); SBAR(); } while (0)
    f32x16 pA0, pA1, pB0, pB1; float mnA, mnB, alA, alB; bf16x8 pa0, pa1, pa2, pa3;
    char* q_lds = lds + LDS_Q + (wid * NQL_ * 64 + lane) * 16;
#pragma unroll
    for (int d0 = 0; d0 < NQL_; ++d0) *(bf16x8*)(q_lds + d0 * 1024) = S.qt[d0];
    SWRITE_HV(0); SBAR();
    if (NT > 1) { SLOAD_H(Kh, Vh, KBASE(1)); }
    SBAR(); qkt<0>(pA0, pA1, K_lds, r32, hi, S.qr, q_lds);
    MASKT(pA0, pA1, 0); partialSM(pA0, pA1, m_reg, mnA, alA);
    if (NT > 1) { VMW(); SWRITE_H(1); }
    __syncthreads();
#define HALF_STEP(PX0, PX1, mnX, alX, PY0, PY1, alY, t, KB, VB, SB) do {                                                      \
        SBAR(); qkt<KB>(PX0, PX1, K_lds, r32, hi, S.qr, q_lds);                                             \
        finishSM(PY0, PY1, alY, l_reg, pa0, pa1, pa2, pa3); SBAR();                                                           \
        if ((t) + 1 < NT) { SLOAD_H(Kh, Vh, KBASE((t) + 1)); SBAR(); }                                               \
        pv_tile<VB>(o, vb0, pa0, pa1, pa2, pa3); MASKT(PX0, PX1, (t)); partialSM(PX0, PX1, m_reg, mnX, alX);                                        \
        __syncthreads();                                                                                                      \
        if ((t) + 1 < NT) { VMW(); SWRITE_H(SB); }                                                                          \
        RESC(alX); __syncthreads(); } while (0)
    for (int t = 1; t + 1 < NT; t += 2) {
        HALF_STEP(pB0, pB1, mnB, alB, pA0, pA1, alA, t, 1, 0, 0);
        HALF_STEP(pA0, pA1, mnA, alA, pB0, pB1, alB, t + 1, 0, 1, 1);
    }
    const bool even = (NT & 1) == 0;
    if (even) { SBAR(); qkt<1>(pB0, pB1, K_lds, r32, hi, S.qr, q_lds); SBAR(); }
    finishSM(pA0, pA1, alA, l_reg, pa0, pa1, pa2, pa3); SBAR();
    SLOAD_H(nxt.K, nxt.V, kbn); SBAR();
#pragma unroll
    for (int d0 = 0; d0 < NQR; ++d0) S.qr[d0] = load8(nxt.Q + (size_t)(wid * QBLK + r32) * QS + d0 * 16 + hi * 8);
#pragma unroll
    for (int d0 = 0; d0 < NQL_; ++d0) S.qt[d0] = load8(nxt.Q + (size_t)(wid * QBLK + r32) * QS + (NQR + d0) * 16 + hi * 8);
    SBAR();
    pv_tile<0>(o, vb0, pa0, pa1, pa2, pa3);
    if (even) { MASKT(pB0, pB1, NT - 1); partialSM(pB0, pB1, m_reg, mnB, alB); __syncthreads(); RESC(alB);
        finishSM(pB0, pB1, alB, l_reg, pa0, pa1, pa2, pa3); SBAR(); pv_tile<1>(o, vb0, pa0, pa1, pa2, pa3); }
    SBAR(); SEAM_K0();
    if (hi == 0) li_l[r32] = l_reg; asm volatile("s_waitcnt lgkmcnt(0)" ::: "memory");
    float rli[16];
#pragma unroll
    for (int r = 0; r < 16; ++r) rli[r] = __builtin_amdgcn_rcpf(li_l[crow(r, hi)]);
    bf16* Ow = cur.O + (size_t)(wid * QBLK) * OS;
    {
        const bool odd = (r32 & 1) != 0; const int colp = r32 & ~1;
#pragma unroll
        for (int r = 0; r < 16; r += 2) { const int orow = crow(r, hi) + (odd ? 1 : 0);
#pragma unroll
            for (int d0 = 0; d0 < 4; ++d0) { const float va = o[d0][r] * rli[r], vb = o[d0][r + 1] * rli[r + 1];
                const float send = odd ? va : vb;
                const float recv = __builtin_bit_cast(float, __builtin_amdgcn_update_dpp(0, __builtin_bit_cast(int, send), 0xB1, 0xf, 0xf, false));
                const float lo = odd ? recv : va, hi2 = odd ? vb : recv;
                *(unsigned*)(Ow + (size_t)orow * OS + d0 * 32 + colp) = cvtpk(lo, hi2); } }
    }
    __syncthreads();
#undef RESC
#undef KBASE
#undef MASKT
#undef SEAM_K0
#undef HALF_STEP
}
#undef VROW
#undef KROW
#undef VMW
#undef VMWN
#undef SLOAD_H
#undef SWRITE_HK
#undef SWRITE_HV
#undef SWRITE_H
__device__ __forceinline__ BlockRef blk_ref(int bh, int qb, const bf16* Q, const bf16* K, const bf16* V, bf16* O) {
    const int b = bh / NH, h = bh % NH; const size_t rowb = (size_t)b * SEQ;
    BlockRef r;
    r.Q = Q + (rowb + (size_t)qb * QB) * QS + h * DK; r.O = O + (rowb + (size_t)qb * QB) * OS + h * DV;
    r.K = K + rowb * KS + h * DK; r.V = V + rowb * VS + h * 256 + 128; r.P0 = qb * QB;
    return r;
}
__device__ __forceinline__ void attn_phase(char* lds, const bf16* Q, const bf16* K, const bf16* V, bf16* O, int vcu, int G) {
    constexpr int NQB = SEQ / QB, NX = NQB / 2, TOTAL = 2 * NH * NX;
    int L = vcu; if (L >= TOTAL) return;
    int bh = L / NX, x = L % NX, pass = 0;
    BlockRef cur = blk_ref(bh, x, Q, K, V, O);
    Seam S;
    attn_prime(cur, SEQ, lds, S);
    for (;;) {
        const bool more_pass = pass == 0, more_item = L + G < TOTAL, last = !more_pass && !more_item;
        int bhn = bh, xn = x, passn = pass + 1, Ln = L;
        if (!more_pass) { passn = 0; Ln = more_item ? L + G : L; bhn = Ln / NX; xn = Ln % NX; }
        const BlockRef nxt = last ? cur : blk_ref(bhn, passn ? NQB - 1 - xn : xn, Q, K, V, O);
        attn_block(cur, nxt, SEQ, SEQ, lds, S);
        if (last) break;
        cur = nxt; bh = bhn; x = xn; pass = passn; L = Ln;
    }
}
#undef KSWZ
#undef SBAR
}
#define GAS __attribute__((address_space(1)))
#define LAS __attribute__((address_space(3)))
typedef unsigned short bf16;
typedef unsigned v4u __attribute__((ext_vector_type(4)));
typedef unsigned v2u __attribute__((ext_vector_type(2)));
typedef float f32x4 __attribute__((ext_vector_type(4)));
constexpr int NWAVES = 8;
constexpr int MTOK = 8192, DM = 2048, SEQL = 4096, CONVD = 1024, QL = 768, KVL = 512, INW = 8512, INWP = 8704, DFF = 5632, NHEAD = 16;
constexpr float EPS = 1e-6f;
constexpr size_t MiB = 1u << 20;
constexpr size_t WS_ZKR = 1, WS_WC = 2, WS_QB = 6, WS_KVB = 12, WS_MLA = 16, WS_WO = 24, WS_WIN = 32, WS_U1 = 66, WS_ZCONV = 98, WS_ZQ = 146, WS_ZKV = 158, WS_ZG = 166;
constexpr size_t WS_CM = 32, WS_QN = 48, WS_KVN = 60, WS_T1 = 68, WS_QRAW = 100, WS_KVRAW = 230, WS_KF = 294, WS_ATT = 32, WS_MIX = 100;
constexpr size_t WS_U2 = 36, WS_UP = 230, WS_DOWN = 176, WS_G = 68, WS_END = 347;
constexpr size_t WS_CST = 342, WS_SNT = 343, WS_KRR = 344, WS_KRSS = 346;
constexpr int LDS_BYTES = 147456;
constexpr int LDS_XCH = 131072;
constexpr int LDS_BARW = LDS_BYTES - 64;
constexpr size_t CTL_BYTES = 131072, WS_ROWSS = 65536;

#define LDS_WAIT() asm volatile("s_waitcnt lgkmcnt(0)" ::: "memory")
#define XB_TMO      128
#define XB_XCNT(j)  (256  + 64 * (j))
#define XB_XSUB(j)  (1280 + 64 * (j))
#define XB_XGEN(j)  (2304 + 64 * (j))
#define XB_TOP      3328
#define XB_TOPGEN   3392
#define XCD_BAR_WORDS 3456
#define XB_SPIN_CAP (1u << 18)

__device__ __forceinline__ unsigned xb_ld(unsigned* p)              { return __hip_atomic_load(p, __ATOMIC_RELAXED, __HIP_MEMORY_SCOPE_AGENT); }
__device__ __forceinline__ unsigned xb_add(unsigned* p, unsigned v) { return __hip_atomic_fetch_add(p, v, __ATOMIC_RELAXED, __HIP_MEMORY_SCOPE_AGENT); }
__device__ __forceinline__ unsigned xb_xcc_id() { return (unsigned)__builtin_amdgcn_s_getreg((3 << 11) | 20) & 0xFu; }
#define XB_SPIN(cond, bar) do { unsigned _sp = 0; while (cond) { __builtin_amdgcn_s_sleep(1); \
    if ((++_sp & 255u) == 0u) { if (xb_ld(&(bar)[XB_TMO])) break; if (_sp > XB_SPIN_CAP) { atomicAdd(&(bar)[XB_TMO], 1u); break; } } } } while (0)

struct XcdBarrier {
    unsigned* bar; unsigned x;
    volatile LAS unsigned* st;
};

__device__ __forceinline__ XcdBarrier xcd_barrier_post(unsigned* bar, volatile LAS unsigned* st) {
    XcdBarrier b; b.bar = bar; b.x = xb_xcc_id(); b.st = st;
    if (threadIdx.x == 0) (void)xb_add(&bar[XB_XCNT(b.x)], 1u);
    return b;
}
__device__ __forceinline__ void xcd_barrier_complete(unsigned* bar, unsigned x, unsigned& nloc, unsigned& nx) {
    const unsigned G = gridDim.x * gridDim.y * gridDim.z;
    unsigned sum, cnt, mine, sp = 0u;
    for (;;) {
        sum = 0u; cnt = 0u; mine = 0u;
#pragma unroll
        for (unsigned j = 0; j < 16; ++j) { const unsigned c = xb_ld(&bar[XB_XCNT(j)]); sum += c; cnt += (c > 0u) ? 1u : 0u; mine = (j == x) ? c : mine; }
        if (sum == G) break;
        __builtin_amdgcn_s_sleep(1);
        if ((++sp & 255u) == 0u) { if (xb_ld(&bar[XB_TMO])) break; if (sp > XB_SPIN_CAP) { atomicAdd(&bar[XB_TMO], 1u); break; } }
    }
    nloc = mine > 0u ? mine : 1u; nx = cnt > 0u ? cnt : 1u;
}

__device__ __forceinline__ void xcd_barrier(const XcdBarrier& b) {
    asm volatile("s_waitcnt vmcnt(0)" ::: "memory");
    __syncthreads();
    if (threadIdx.x == 0) {
        unsigned* bar = b.bar;
        __builtin_amdgcn_s_waitcnt(0);
        unsigned nloc = b.st[0], nx = b.st[1];
        if (nloc == 0u) { xcd_barrier_complete(bar, b.x, nloc, nx); b.st[0] = nloc; b.st[1] = nx; }
        const unsigned old = xb_add(&bar[XB_XSUB(b.x)], 1u);
        const unsigned gen = old / nloc;
        if (old + 1u == (gen + 1u) * nloc) {
            __builtin_amdgcn_fence(__ATOMIC_RELEASE, "agent");
            asm volatile("s_waitcnt vmcnt(0)" ::: "memory");
            const unsigned og = xb_add(&bar[XB_TOP], 1u);
            const unsigned tg = og / nx;
            if (og + 1u == (tg + 1u) * nx) xb_add(&bar[XB_TOPGEN], 1u);
            else XB_SPIN(xb_ld(&bar[XB_TOPGEN]) == tg, bar);
            __builtin_amdgcn_fence(__ATOMIC_ACQUIRE, "agent");
            asm volatile("s_waitcnt vmcnt(0)" ::: "memory");
        } else {
            XB_SPIN(xb_ld(&bar[XB_TOPGEN]) == gen, bar);
            __builtin_amdgcn_fence(__ATOMIC_ACQUIRE, "agent");
            asm volatile("s_waitcnt vmcnt(0)" ::: "memory");
        }
    }
    __syncthreads();
}

__device__ __forceinline__ unsigned xcd_barrier_arrive(const XcdBarrier& b) {
    asm volatile("s_waitcnt vmcnt(0)" ::: "memory");
    __syncthreads();
    unsigned gen = 0u;
    if (threadIdx.x == 0) {
        unsigned* bar = b.bar;
        __builtin_amdgcn_s_waitcnt(0);
        unsigned nloc = b.st[0], nx = b.st[1];
        if (nloc == 0u) { xcd_barrier_complete(bar, b.x, nloc, nx); b.st[0] = nloc; b.st[1] = nx; }
        const unsigned old = xb_add(&bar[XB_XSUB(b.x)], 1u);
        gen = old / nloc;
        if (old + 1u == (gen + 1u) * nloc) {
            __builtin_amdgcn_fence(__ATOMIC_RELEASE, "agent");
            asm volatile("s_waitcnt vmcnt(0)" ::: "memory");
            const unsigned og = xb_add(&bar[XB_TOP], 1u);
            const unsigned tg = og / nx;
            if (og + 1u == (tg + 1u) * nx) xb_add(&bar[XB_TOPGEN], 1u);
            asm volatile("s_waitcnt vmcnt(0)" ::: "memory");
        }
    }
    return gen;
}
__device__ __forceinline__ void xcd_barrier_wait(const XcdBarrier& b, unsigned gen) {
    asm volatile("s_waitcnt vmcnt(0)" ::: "memory");
    if (threadIdx.x == 0) {
        unsigned* bar = b.bar;
        XB_SPIN(xb_ld(&bar[XB_TOPGEN]) == gen, bar);
        __builtin_amdgcn_fence(__ATOMIC_ACQUIRE, "agent");
        asm volatile("s_waitcnt vmcnt(0)" ::: "memory");
    }
    __syncthreads();
}

__device__ __forceinline__ unsigned f2bf(float f) { unsigned u = __builtin_bit_cast(unsigned, f); return (u + 0x7fffu + ((u >> 16) & 1u)) >> 16; }
__device__ __forceinline__ unsigned pk2(float lo, float hi) { return pg8::cvt_pk_bf16(lo, hi); }
__device__ __forceinline__ float bf2f(bf16 h) { return __uint_as_float((unsigned)h << 16); }
__device__ __forceinline__ float wave_sum(float v) {
#pragma unroll
    for (int o = 1; o < 64; o <<= 1) v += __shfl_xor(v, o);
    return v;
}
__device__ __forceinline__ void unpack8(v4u w, float (&f)[8]) {
    f[0] = __uint_as_float(w.x << 16); f[1] = __uint_as_float(w.x & 0xffff0000u); f[2] = __uint_as_float(w.y << 16); f[3] = __uint_as_float(w.y & 0xffff0000u);
    f[4] = __uint_as_float(w.z << 16); f[5] = __uint_as_float(w.z & 0xffff0000u); f[6] = __uint_as_float(w.w << 16); f[7] = __uint_as_float(w.w & 0xffff0000u);
}
__device__ __forceinline__ v4u pack8f(const float (&f)[8]) { v4u o; o.x = pk2(f[0], f[1]); o.y = pk2(f[2], f[3]); o.z = pk2(f[4], f[5]); o.w = pk2(f[6], f[7]); return o; }
constexpr int TP = 65, TSCR_BYTES = 64 * TP * 4;
struct TJob { const float* W; bf16* WT; const float* kscale; int K, N, kb, nb, drow0, perm; };
__device__ __forceinline__ void tr_load(const TJob& j, f32x4 (&v)[16], int lane) {
    const int nq = lane & 15, kr = lane >> 4;
    const float* src = j.W + (size_t)(64 * j.kb + kr) * j.N + 64 * j.nb + 4 * nq;
#pragma unroll
    for (int i = 0; i < 16; ++i) v[i] = __builtin_nontemporal_load((const f32x4*)(src + (size_t)(4 * i) * j.N));
}
__device__ __forceinline__ void tr_store(const TJob& j, const f32x4 (&v)[16], LAS float* scr, int lane) {
    const int k0 = 64 * j.kb, nq = lane & 15, kr = lane >> 4;
#pragma unroll
    for (int i = 0; i < 16; ++i) { LAS float* d = scr + (4 * i + kr) * TP + 4 * nq; const float sc = j.kscale ? j.kscale[k0 + 4 * i + kr] : 1.f; d[0] = v[i].x * sc; d[1] = v[i].y * sc; d[2] = v[i].z * sc; d[3] = v[i].w * sc; }
    LDS_WAIT(); asm volatile("" ::: "memory");
    const int c = lane & 7;
#pragma unroll
    for (int jj = 0; jj < 8; ++jj) { const int n = (lane >> 3) + 8 * jj; const LAS float* q = scr + (8 * c) * TP + n; const int nd = j.perm ? 32 * ((n >> 4) & 1) + 8 * ((n >> 2) & 3) + 4 * (n >> 5) + (n & 3) : n;
        v4u o; o.x = pk2(q[0 * TP], q[1 * TP]); o.y = pk2(q[2 * TP], q[3 * TP]); o.z = pk2(q[4 * TP], q[5 * TP]); o.w = pk2(q[6 * TP], q[7 * TP]);
        *(v4u*)(j.WT + (size_t)(j.drow0 + nd) * j.K + k0 + 8 * c) = o; }
    LDS_WAIT(); asm volatile("" ::: "memory");
}
__device__ __forceinline__ void rms_row_2048(const float* xrow, const float* g, bf16* orow, int lane) {
    const f32x4* xr = (const f32x4*)xrow + lane; const f32x4* gr = (const f32x4*)g + lane;
    f32x4 v[8]; float s = 0.f;
#pragma unroll
    for (int j = 0; j < 8; ++j) { v[j] = __builtin_nontemporal_load(xr + 64 * j); s += (v[j].x * v[j].x + v[j].y * v[j].y) + (v[j].z * v[j].z + v[j].w * v[j].w); }
    const float r = rsqrtf(wave_sum(s) * (1.f / 2048.f) + EPS);
    v2u* o8 = (v2u*)orow + lane;
#pragma unroll
    for (int j = 0; j < 8; ++j) { const f32x4 gg = gr[64 * j]; v2u o; o.x = pk2(v[j].x * r * gg.x, v[j].y * r * gg.y); o.y = pk2(v[j].z * r * gg.z, v[j].w * r * gg.w); o8[64 * j] = o; }
}
__device__ const float INV_FREQ[32] = {1.000000000e+00f, 7.498942614e-01f, 5.623413324e-01f, 4.216965139e-01f, 3.162277639e-01f, 2.371373773e-01f, 1.778279394e-01f, 1.333521307e-01f,
    1.000000015e-01f, 7.498941571e-02f, 5.623413250e-02f, 4.216965288e-02f, 3.162277490e-02f, 2.371373773e-02f, 1.778279431e-02f, 1.333521493e-02f,
    9.999999776e-03f, 7.498941850e-03f, 5.623413250e-03f, 4.216964822e-03f, 3.162277630e-03f, 2.371373586e-03f, 1.778279431e-03f, 1.333521446e-03f,
    1.000000047e-03f, 7.498942432e-04f, 5.623413017e-04f, 4.216965172e-04f, 3.162277571e-04f, 2.371373703e-04f, 1.778279402e-04f, 1.333521504e-04f};


constexpr int I_IN = (DM / 64) * (INW / 64), I_WC = (CONVD / 64) * (DM / 64), I_QB = (QL / 64) * (3072 / 64), I_KVB = (KVL / 64) * (4096 / 64), I_SQ = (DM / 64) * (DM / 64);
constexpr int I_UP = (DM / 64) * (2 * DFF / 64), I_DN = (DFF / 64) * (DM / 64);
__device__ __forceinline__ TJob job0(int it, const float* w_in, const float* w_co, const float* w_qb, const float* w_kvb, const float* w_mla, const float* w_o,
                                     bf16* win_t, bf16* wc_t, bf16* qb_t, bf16* kvb_t, bf16* mla_t, bf16* wo_t) {
    int r = it; TJob j; j.kscale = nullptr; j.perm = 0;
    if (r < I_IN) { const int nblk = INW / 64; j.kb = r / nblk; j.nb = r % nblk; const int n0 = 64 * j.nb;
        j.drow0 = n0 < 4352 ? n0 : (n0 < 4416 ? 8448 + (n0 - 4352) : 4352 + (n0 - 4416)); j.W = w_in; j.K = DM; j.N = INW; j.WT = win_t; return j; } r -= I_IN;
    if (r < I_WC) { const int nblk = DM / 64; j.kb = r / nblk; j.nb = r % nblk; j.drow0 = 64 * j.nb; j.W = w_co; j.K = CONVD; j.N = DM; j.WT = wc_t; return j; } r -= I_WC;
    if (r < I_QB) { const int nblk = 3072 / 64; j.kb = r / nblk; j.nb = r % nblk; const int hh = j.nb / 3, part = j.nb % 3; j.drow0 = 256 * hh + 64 * part; j.perm = part == 2 ? 1 : 0;
        j.W = w_qb; j.K = QL; j.N = 3072; j.WT = qb_t; return j; } r -= I_QB;
    if (r < I_KVB) { const int nblk = 4096 / 64; j.kb = r / nblk; j.nb = r % nblk; j.drow0 = 64 * j.nb; j.W = w_kvb; j.K = KVL; j.N = 4096; j.WT = kvb_t; return j; } r -= I_KVB;
    const int nblk = DM / 64; const bool second = r >= I_SQ; if (second) r -= I_SQ;
    j.kb = r / nblk; j.nb = r % nblk; j.drow0 = 64 * j.nb; j.W = second ? w_o : w_mla; j.K = DM; j.N = DM; j.WT = second ? wo_t : mla_t; return j;
}
__device__ __forceinline__ TJob job8(int it, const float* w_up, const float* w_dn, const float* ln2g, bf16* up_t, bf16* down_t) {
    int r = it; TJob j; j.perm = 0;
    if (r < I_UP) { const int nblk = 2 * DFF / 64; j.kb = r / nblk; j.nb = r % nblk; const int n0 = 64 * j.nb, hf = n0 >= DFF ? 1 : 0, jc = n0 - hf * DFF;
        j.drow0 = 256 * (jc / 128) + 128 * hf + (jc % 128); j.W = w_up; j.K = DM; j.N = 2 * DFF; j.WT = up_t; j.kscale = ln2g; return j; } r -= I_UP;
    const int nblk = DM / 64; j.kb = r / nblk; j.nb = r % nblk; j.drow0 = 64 * j.nb; j.W = w_dn; j.K = DFF; j.N = DM; j.WT = down_t; j.kscale = nullptr; return j;
}
struct Args { const float* in[20]; float* out; unsigned char* ws; };

__global__ void __launch_bounds__(NWAVES * 64, 2) fwd_kernel(Args a) {
    extern __shared__ __attribute__((aligned(16))) unsigned char lds[];
    cg::grid_group grid = cg::this_grid();
    const int G = gridDim.x, bx = blockIdx.x, vcu = (G % 8 == 0) ? (bx % 8) * (G / 8) + bx / 8 : bx;
    const int NGW = G * NWAVES;
    LAS unsigned char* ldsl = (LAS unsigned char*)lds;
    if (threadIdx.x < 16) ((LAS unsigned*)(ldsl + LDS_BARW))[threadIdx.x] = 0u;
    __syncthreads();
    const XcdBarrier bar = xcd_barrier_post((unsigned*)a.ws, (volatile LAS unsigned*)(ldsl + LDS_BARW));
#define PHASE_IDS() int tid_ = threadIdx.x; asm volatile("" : "+v"(tid_)); const int tid = tid_, lane = tid & 63, wave = __builtin_amdgcn_readfirstlane(tid >> 6), gw = vcu * NWAVES + wave; \
    LAS float* scr = (LAS float*)(ldsl + wave * TSCR_BYTES); (void)scr; (void)gw; (void)lane; (void)tid
    unsigned char* ws = a.ws;
    const float* x = a.in[0]; const int* positions = (const int*)a.in[1];
    bf16* zkr = (bf16*)(ws + WS_ZKR * MiB); bf16* wc_t = (bf16*)(ws + WS_WC * MiB); bf16* qb_t = (bf16*)(ws + WS_QB * MiB); bf16* kvb_t = (bf16*)(ws + WS_KVB * MiB);
    bf16* mla_t = (bf16*)(ws + WS_MLA * MiB); bf16* wo_t = (bf16*)(ws + WS_WO * MiB); bf16* win_t = (bf16*)(ws + WS_WIN * MiB); bf16* u1 = (bf16*)(ws + WS_U1 * MiB);
    bf16* zconv = (bf16*)(ws + WS_ZCONV * MiB); bf16* zq = (bf16*)(ws + WS_ZQ * MiB); bf16* zkv = (bf16*)(ws + WS_ZKV * MiB); bf16* zg = (bf16*)(ws + WS_ZG * MiB);
    bf16* cm = (bf16*)(ws + WS_CM * MiB); bf16* qn = (bf16*)(ws + WS_QN * MiB); bf16* kvn = (bf16*)(ws + WS_KVN * MiB); bf16* t1 = (bf16*)(ws + WS_T1 * MiB);
    bf16* qraw = (bf16*)(ws + WS_QRAW * MiB); bf16* kvraw = (bf16*)(ws + WS_KVRAW * MiB); bf16* kf = (bf16*)(ws + WS_KF * MiB); bf16* attb = (bf16*)(ws + WS_ATT * MiB);
    bf16* mixb = (bf16*)(ws + WS_MIX * MiB); float* rowss = (float*)(ws + WS_ROWSS);
    float* cst = (float*)(ws + WS_CST * MiB); float* snt = (float*)(ws + WS_SNT * MiB); float* krr = (float*)(ws + WS_KRR * MiB); float* krss = (float*)(ws + WS_KRSS * MiB);
    bf16* down_t = (bf16*)(ws + WS_DOWN * MiB); bf16* gbuf = (bf16*)(ws + WS_G * MiB); bf16* u2 = (bf16*)(ws + WS_U2 * MiB); bf16* up_t = (bf16*)(ws + WS_UP * MiB);

    {
        PHASE_IDS();
        {
            f32x4 va[16], vb[16]; int it = gw;
            if (it < I_IN) { TJob ja = job0(it, a.in[3], a.in[6], a.in[8], a.in[10], a.in[13], a.in[14], win_t, wc_t, qb_t, kvb_t, mla_t, wo_t); tr_load(ja, va, lane);
                for (;;) {
                    const int itb = it + NGW; TJob jb; const bool hb = itb < I_IN; if (hb) { jb = job0(itb, a.in[3], a.in[6], a.in[8], a.in[10], a.in[13], a.in[14], win_t, wc_t, qb_t, kvb_t, mla_t, wo_t); tr_load(jb, vb, lane); }
                    tr_store(ja, va, scr, lane); if (!hb) break;
                    const int itc = itb + NGW; const bool hc = itc < I_IN; if (hc) { ja = job0(itc, a.in[3], a.in[6], a.in[8], a.in[10], a.in[13], a.in[14], win_t, wc_t, qb_t, kvb_t, mla_t, wo_t); tr_load(ja, va, lane); }
                    tr_store(jb, vb, scr, lane); if (!hc) break;
                    it = itc;
                } }
        }
        { v4u* p = (v4u*)(win_t + (size_t)INW * DM); const int n16 = (INWP - INW) * DM * 2 / 16; const v4u z = {0u, 0u, 0u, 0u};
          for (int i = (vcu * NWAVES * 64) + tid; i < n16; i += G * NWAVES * 64) p[i] = z;
          constexpr int PR16 = 64 * QL * 2 / 16;
          for (int i = (vcu * NWAVES * 64) + tid; i < NHEAD * PR16; i += G * NWAVES * 64) ((v4u*)(qb_t + (size_t)(256 * (i / PR16) + 192) * QL))[i % PR16] = z; }
        for (int m = gw; m < MTOK; m += NGW) rms_row_2048(x + (size_t)m * DM, a.in[2], u1 + (size_t)m * DM, lane);
    }
    xcd_barrier(bar);
    if (__builtin_expect(gridDim.y > 1u, 0)) grid.sync();
    {
        pg8::Gemm g{u1, win_t, MTOK, INWP, DM}; pg8::StaticOrder S; S.init(MTOK, INWP, G, bx);
        pg8::EpiIn E{zconv, zq, zkv, zg, zkr, a.in[4]};
        pg8::gemm_phase<pg8::EpiIn, pg8::StaticOrder, true, true>(ldsl, g, S, E);
        {
            PHASE_IDS();
            constexpr int NUNITS = (MTOK / 256) * (INWP / 256), NDEF = I_IN + I_WC + I_QB + I_KVB + 2 * I_SQ;
            const int iL = (NUNITS - 1) / G, nlast = NUNITS - iL * G, idle = G - nlast;
            const int npart = idle > 0 ? idle : G, rank = idle > 0 ? bx - nlast : bx;
            if (rank >= 0) {
        {
                f32x4 va[16], vb[16]; int it = I_IN + rank * NWAVES + wave;
                if (it < NDEF) { TJob ja = job0(it, a.in[3], a.in[6], a.in[8], a.in[10], a.in[13], a.in[14], win_t, wc_t, qb_t, kvb_t, mla_t, wo_t); tr_load(ja, va, lane);
                    for (;;) {
                        const int itb = it + npart * NWAVES; TJob jb; const bool hb = itb < NDEF; if (hb) { jb = job0(itb, a.in[3], a.in[6], a.in[8], a.in[10], a.in[13], a.in[14], win_t, wc_t, qb_t, kvb_t, mla_t, wo_t); tr_load(jb, vb, lane); }
                        tr_store(ja, va, scr, lane); if (!hb) break;
                        const int itc = itb + npart * NWAVES; const bool hc = itc < NDEF; if (hc) { ja = job0(itc, a.in[3], a.in[6], a.in[8], a.in[10], a.in[13], a.in[14], win_t, wc_t, qb_t, kvb_t, mla_t, wo_t); tr_load(ja, va, lane); }
                        tr_store(jb, vb, scr, lane); if (!hc) break;
                        it = itc;
                    } }
            }
            }
        }
    }
    xcd_barrier(bar);
    {
        PHASE_IDS();
        const float* cw = a.in[5]; const float* qg = a.in[7]; const float* kvg = a.in[9];
        const float gkr = a.in[12][128 + lane], ifq = INV_FREQ[lane & 31];
        for (int m = gw; m < MTOK; m += NGW) {
            const int t = m & (SEQL - 1);
            const bf16* zr = zconv + (size_t)m * 3072;
#pragma unroll
            for (int ch = 0; ch < 2; ++ch) {
                const int c = ch * 512 + lane * 8;
                const v4u z4 = {0u, 0u, 0u, 0u};
                const v4u zb = *(const v4u*)(zr + c), zc0 = *(const v4u*)(zr + 1024 + c), zv0 = *(const v4u*)(zr + 2048 + c);
                const v4u zc1 = t >= 1 ? *(const v4u*)(zr - 3072 + 1024 + c) : z4, zv1 = t >= 1 ? *(const v4u*)(zr - 3072 + 2048 + c) : z4;
                const v4u zc2 = t >= 2 ? *(const v4u*)(zr - 6144 + 1024 + c) : z4, zv2 = t >= 2 ? *(const v4u*)(zr - 6144 + 2048 + c) : z4;
                float fb[8], fc0[8], fv0[8], fc1[8], fv1[8], fc2[8], fv2[8], w0[8], w1[8], w2[8], o[8];
                unpack8(zb, fb); unpack8(zc0, fc0); unpack8(zv0, fv0); unpack8(zc1, fc1); unpack8(zv1, fv1); unpack8(zc2, fc2); unpack8(zv2, fv2);
                *(f32x4*)&w0[0] = *(const f32x4*)(cw + c); *(f32x4*)&w0[4] = *(const f32x4*)(cw + c + 4);
                *(f32x4*)&w1[0] = *(const f32x4*)(cw + 1024 + c); *(f32x4*)&w1[4] = *(const f32x4*)(cw + 1024 + c + 4);
                *(f32x4*)&w2[0] = *(const f32x4*)(cw + 2048 + c); *(f32x4*)&w2[4] = *(const f32x4*)(cw + 2048 + c + 4);
#pragma unroll
                for (int e = 0; e < 8; ++e) o[e] = fb[e] * (w0[e] * (fc2[e] * fv2[e]) + w1[e] * (fc1[e] * fv1[e]) + w2[e] * (fc0[e] * fv0[e]));
                *(v4u*)(cm + (size_t)m * CONVD + c) = pack8f(o);
            }
            {
                const bf16* qr = zq + (size_t)m * QL;
                const v4u qa = *(const v4u*)(qr + lane * 8); const v2u qb2 = *(const v2u*)(qr + 512 + lane * 4);
                float fa[8]; unpack8(qa, fa);
                float fb4[4] = {__uint_as_float(qb2.x << 16), __uint_as_float(qb2.x & 0xffff0000u), __uint_as_float(qb2.y << 16), __uint_as_float(qb2.y & 0xffff0000u)};
                float s = 0.f;
#pragma unroll
                for (int e = 0; e < 8; ++e) s += fa[e] * fa[e];
#pragma unroll
                for (int e = 0; e < 4; ++e) s += fb4[e] * fb4[e];
                const float r = rsqrtf(wave_sum(s) * (1.f / 768.f) + EPS);
                const f32x4 g0 = *(const f32x4*)(qg + lane * 8), g1 = *(const f32x4*)(qg + lane * 8 + 4), g2 = *(const f32x4*)(qg + 512 + lane * 4);
                float oa[8] = {fa[0] * r * g0.x, fa[1] * r * g0.y, fa[2] * r * g0.z, fa[3] * r * g0.w, fa[4] * r * g1.x, fa[5] * r * g1.y, fa[6] * r * g1.z, fa[7] * r * g1.w};
                *(v4u*)(qn + (size_t)m * QL + lane * 8) = pack8f(oa);
                v2u ob; ob.x = pk2(fb4[0] * r * g2.x, fb4[1] * r * g2.y); ob.y = pk2(fb4[2] * r * g2.z, fb4[3] * r * g2.w);
                *(v2u*)(qn + (size_t)m * QL + 512 + lane * 4) = ob;
            }
            {
                const float ang = (float)positions[m] * ifq; const double rev = (double)ang * 0.15915494309189535; const float frc = (float)(rev - __builtin_floor(rev));
                const float cs = __builtin_amdgcn_cosf(frc), sn = __builtin_amdgcn_sinf(frc);
                if (lane < 32) { cst[(size_t)m * 32 + lane] = cs; snt[(size_t)m * 32 + lane] = sn; }
                const float kr = bf2f(zkr[(size_t)m * 64 + lane]); const float kss = wave_sum(kr * kr); if (lane == 0) krss[m] = kss;
                const float v = kr * gkr, pt = __shfl_xor(v, 32);
                krr[(size_t)m * 64 + lane] = lane < 32 ? v * cs - pt * sn : v * cs + pt * sn;
            }
            {
                const v4u ka = *(const v4u*)(zkv + (size_t)m * KVL + lane * 8);
                float fa[8]; unpack8(ka, fa); float s = 0.f;
#pragma unroll
                for (int e = 0; e < 8; ++e) s += fa[e] * fa[e];
                const float r = rsqrtf(wave_sum(s) * (1.f / 512.f) + EPS);
                const f32x4 g0 = *(const f32x4*)(kvg + lane * 8), g1 = *(const f32x4*)(kvg + lane * 8 + 4);
                float oa[8] = {fa[0] * r * g0.x, fa[1] * r * g0.y, fa[2] * r * g0.z, fa[3] * r * g0.w, fa[4] * r * g1.x, fa[5] * r * g1.y, fa[6] * r * g1.z, fa[7] * r * g1.w};
                *(v4u*)(kvn + (size_t)m * KVL + lane * 8) = pack8f(oa);
            }
        }
    }
    xcd_barrier(bar);
    {
        { pg8::Gemm g{cm, wc_t, MTOK, DM, CONVD}; pg8::StaticOrder S; S.init(MTOK, DM, G, bx);
          pg8::EpiFma E{t1, DM, zg, 4096, 0, nullptr, 0};
          pg8::gemm_phase<pg8::EpiFma, pg8::StaticOrder, true, true>(ldsl, g, S, E); }
        { pg8::Gemm g{qn, qb_t, MTOK, 4096, QL}; pg8::StaticOrder S; S.init(MTOK, 4096, G, bx);
          pg8::EpiQ E{qraw, a.in[11], cst, snt, (LAS float*)(ldsl + LDS_XCH)};
          pg8::gemm_phase<pg8::EpiQ, pg8::StaticOrder, true, true>(ldsl, g, S, E); }
        { pg8::Gemm g{kvn, kvb_t, MTOK, 4096, KVL}; pg8::StaticOrder S; S.init(MTOK, 4096, G, bx);
          pg8::EpiKV E{kf, kvraw, a.in[12], krr, krss, (LAS float*)(ldsl + LDS_XCH)};
          pg8::gemm_phase<pg8::EpiKV, pg8::StaticOrder, true, true>(ldsl, g, S, E); }
    }
    xcd_barrier(bar);
    att::attn_phase((char*)lds, (const att::bf16*)qraw, (const att::bf16*)kf, (const att::bf16*)kvraw, (att::bf16*)attb, vcu, G);
    xcd_barrier(bar);
    {
        pg8::Gemm g{attb, mla_t, MTOK, DM, DM}; pg8::StaticOrder S; S.init(MTOK, DM, G, bx);
        pg8::EpiFma E{mixb, DM, zg, 4096, 2048, t1, DM};
        pg8::gemm_phase<pg8::EpiFma, pg8::StaticOrder, true, true>(ldsl, g, S, E);
    }
    const unsigned seam67 = xcd_barrier_arrive(bar);
    {
        PHASE_IDS();
        {
            constexpr int NITEMS = I_UP;     f32x4 va[16], vb[16]; int it = gw;
            if (it < NITEMS) { TJob ja = job8(it, a.in[16], a.in[19], a.in[15], up_t, down_t); tr_load(ja, va, lane);
                for (;;) {
                    const int itb = it + NGW; TJob jb; const bool hb = itb < NITEMS; if (hb) { jb = job8(itb, a.in[16], a.in[19], a.in[15], up_t, down_t); tr_load(jb, vb, lane); }
                    tr_store(ja, va, scr, lane); if (!hb) break;
                    const int itc = itb + NGW; const bool hc = itc < NITEMS; if (hc) { ja = job8(itc, a.in[16], a.in[19], a.in[15], up_t, down_t); tr_load(ja, va, lane); }
                    tr_store(jb, vb, scr, lane); if (!hc) break;
                    it = itc;
                } }
        }
    }
    xcd_barrier_wait(bar, seam67);
    {
        pg8::Gemm g{mixb, wo_t, MTOK, DM, DM}; pg8::StaticOrder S; S.init(MTOK, DM, G, bx);
        pg8::EpiResNorm E{x, a.out, u2, rowss, DM};
        pg8::gemm_phase<pg8::EpiResNorm, pg8::StaticOrder, true, true>(ldsl, g, S, E);
    }
    xcd_barrier(bar);
    {
        pg8::Gemm g{u2, up_t, MTOK, 2 * DFF, DM}; pg8::UpOrder S; S.init(G, bx);
        pg8::EpiUpGate E{gbuf, a.in[17], a.in[18], (LAS float*)(ldsl + LDS_XCH), rowss};
        pg8::gemm_phase<pg8::EpiUpGate, pg8::UpOrder, true, true>(ldsl, g, S, E);
        {
            PHASE_IDS();
            constexpr int NUNITS = 34 * 44;
            const int iL = (NUNITS - 1) / G, nlast = NUNITS - iL * G, idle = G - nlast;
            const int npart = idle > 0 ? idle : G, rank = idle > 0 ? bx - nlast : bx;
            if (rank >= 0)
            {
                constexpr int NITEMS = I_UP + I_DN; f32x4 va[16], vb[16]; int it = I_UP + rank * NWAVES + wave;
                if (it < NITEMS) { TJob ja = job8(it, a.in[16], a.in[19], a.in[15], up_t, down_t); tr_load(ja, va, lane);
                    for (;;) {
                        const int itb = it + npart * NWAVES; TJob jb; const bool hb = itb < NITEMS; if (hb) { jb = job8(itb, a.in[16], a.in[19], a.in[15], up_t, down_t); tr_load(jb, vb, lane); }
                        tr_store(ja, va, scr, lane); if (!hb) break;
                        const int itc = itb + npart * NWAVES; const bool hc = itc < NITEMS; if (hc) { ja = job8(itc, a.in[16], a.in[19], a.in[15], up_t, down_t); tr_load(ja, va, lane); }
                        tr_store(jb, vb, scr, lane); if (!hc) break;
                        it = itc;
                    } }
            }
        }
    }
    xcd_barrier(bar);
    {
        pg8::Gemm g{gbuf, down_t, MTOK, DM, DFF}; pg8::StaticOrder S; S.init(MTOK, DM, G, bx);
        pg8::EpiResF32 E{a.out, a.out, DM, true};
        pg8::gemm_phase<pg8::EpiResF32, pg8::StaticOrder, true, true>(ldsl, g, S, E);
    }
}

extern "C" void kernel_launch(void* const* d_in, const int* in_sizes, int n_in, void* d_out, int out_size, void* d_ws, size_t ws_size, hipStream_t stream) {
    static int grid = 0;
    if (grid == 0) {
        if (n_in != 20 || out_size != MTOK * DM || ws_size < WS_END * MiB) { fprintf(stderr, "kernel_launch: unexpected shapes (n_in %d, out %d, ws %zu)\n", n_in, out_size, ws_size); grid = -1; return; }
        int dev = 0, cus = 0, per_cu = 0;
        (void)hipGetDevice(&dev); (void)hipDeviceGetAttribute(&cus, hipDeviceAttributeMultiprocessorCount, dev);
        if (hipFuncSetAttribute((const void*)fwd_kernel, hipFuncAttributeMaxDynamicSharedMemorySize, LDS_BYTES) != hipSuccess) { fprintf(stderr, "kernel_launch: hipFuncSetAttribute failed\n"); grid = -1; return; }
        if (hipOccupancyMaxActiveBlocksPerMultiprocessor(&per_cu, (const void*)fwd_kernel, NWAVES * 64, LDS_BYTES) != hipSuccess || per_cu < 1) { fprintf(stderr, "kernel_launch: occupancy query says %d blocks per CU\n", per_cu); grid = -1; return; }
        grid = cus;
    }
    if (grid < 0) return;
    if (hipMemsetAsync(d_ws, 0, CTL_BYTES, stream) != hipSuccess) { fprintf(stderr, "kernel_launch: memset of the barrier words failed\n"); return; }
    Args a{};
    for (int i = 0; i < 20; ++i) a.in[i] = (const float*)d_in[i];
    a.out = (float*)d_out; a.ws = (unsigned char*)d_ws;
    void* args[] = {&a};
    hipError_t e = hipLaunchCooperativeKernel((const void*)fwd_kernel, dim3(grid), dim3(NWAVES * 64), args, LDS_BYTES, stream);
    if (e != hipSuccess) fprintf(stderr, "kernel_launch: cooperative launch failed: %s (grid %d)\n", hipGetErrorString(e), grid);
}
```
